# Optimizing an MI355X kernel written in HIP

```python
import jax, jax.numpy as jnp
from jax import lax
import numpy as np

D_MODEL = 2048
BATCH = 4
SEQ = 4096
DEPTH = 1

HEAD_DIM = 128
N_Q_HEADS = 8
N_KV_HEADS = 2
Q_GROUP = N_Q_HEADS // N_KV_HEADS
ATTN_W = N_Q_HEADS * HEAD_DIM
KV_W = N_KV_HEADS * HEAD_DIM
Q_BLOCK = 128
ROPE_AXIS_DIM = HEAD_DIM // 2
ROPE_THETA = 10000.0
GRID_W = 64
CONV_W = D_MODEL // 2
CONV_K = 3
OFF_Q = 0
OFF_K = OFF_Q + ATTN_W
OFF_V = OFF_K + KV_W
OFF_CH = OFF_V + KV_W
OFF_CB = OFF_CH + CONV_W
OFF_CC = OFF_CB + CONV_W
OFF_GA = OFF_CC + CONV_W
OFF_GC = OFF_GA + D_MODEL
W_IN = OFF_GC + D_MODEL
PEER_HEADS = 8
PEER_N_KEYS = 128
PEER_N_EXPERTS = PEER_N_KEYS * PEER_N_KEYS
PEER_DK = 256
PEER_HALF = PEER_DK // 2
PEER_TOPK = 16
PEER_CHUNK = 128
PLE_DIM = 256
EPS = 1e-6

kernel_name = 'hybrid_gqa_shortconv_peer_encoder_block'


def rms_norm(x, g):
    xf = x.astype(jnp.float32)
    y = xf * lax.rsqrt(jnp.mean(xf * xf, axis=-1, keepdims=True) + EPS)
    return (y * g.astype(jnp.float32)).astype(x.dtype)


def axial_rope_tables(S):
    rows = S // GRID_W
    row = jnp.repeat(jnp.arange(rows, dtype=jnp.int32), GRID_W, total_repeat_length=S)
    col = jnp.tile(jnp.arange(GRID_W, dtype=jnp.int32), rows)
    inv = ROPE_THETA ** (-jnp.arange(0, ROPE_AXIS_DIM, 2, dtype=jnp.float32) / ROPE_AXIS_DIM)
    ang_r = row.astype(jnp.float32)[:, None] * inv[None, :]
    ang_c = col.astype(jnp.float32)[:, None] * inv[None, :]
    ang = jnp.concatenate([ang_r, ang_r, ang_c, ang_c], axis=-1)
    return jnp.cos(ang), jnp.sin(ang)


def apply_rope(x, cos, sin):
    xf = x.astype(jnp.float32)
    xs = xf.reshape(*x.shape[:-1], 2, 2, ROPE_AXIS_DIM // 2)
    rot = jnp.stack([-xs[..., 1, :], xs[..., 0, :]], axis=-2).reshape(x.shape)
    return (xf * cos[None, :, None, :] + rot * sin[None, :, None, :]).astype(x.dtype)


def block_attention(q, k, v):
    B, S = q.shape[0], q.shape[1]
    nblk = S // Q_BLOCK
    qb = q.reshape(B, nblk, Q_BLOCK, N_KV_HEADS, Q_GROUP, HEAD_DIM).transpose(1, 0, 3, 4, 2, 5)
    kt = k.transpose(0, 2, 1, 3)
    vt = v.transpose(0, 2, 1, 3)
    scale = HEAD_DIM ** -0.5

    def one_block(qblk):
        s = jnp.einsum('bkgqd,bksd->bkgqs', qblk, kt).astype(jnp.float32) * scale
        pr = jax.nn.softmax(s, axis=-1).astype(vt.dtype)
        return jnp.einsum('bkgqs,bksd->bkgqd', pr, vt)

    o = lax.map(one_block, qb)
    return o.transpose(1, 0, 4, 2, 3, 5).reshape(B, S, ATTN_W)


def short_conv(u, w):
    return lax.conv_general_dilated(
        u, w[:, None, :].astype(u.dtype), window_strides=(1,), padding=((1, 1),),
        dimension_numbers=('NWC', 'WIO', 'NWC'), feature_group_count=u.shape[-1])


def peer(h, w_q, sub_keys, u, v):
    B, S, D = h.shape
    T = B * S
    hc = h.reshape(T // PEER_CHUNK, PEER_CHUNK, D)

    def one_chunk(xc):
        q = (xc @ w_q).reshape(PEER_CHUNK, PEER_HEADS, 2, PEER_HALF)
        s = jnp.einsum('thpc,hpnc->thpn', q, sub_keys).astype(jnp.float32)
        sv, si = lax.top_k(s, PEER_TOPK)
        cand = (sv[:, :, 0, :, None] + sv[:, :, 1, None, :]).reshape(PEER_CHUNK, PEER_HEADS, PEER_TOPK * PEER_TOPK)
        cidx = (si[:, :, 0, :, None] * PEER_N_KEYS + si[:, :, 1, None, :]).reshape(PEER_CHUNK, PEER_HEADS, PEER_TOPK * PEER_TOPK)
        tv, tpos = lax.top_k(cand, PEER_TOPK)
        eidx = jnp.take_along_axis(cidx, tpos, axis=-1)
        gate = jax.nn.softmax(tv, axis=-1).astype(xc.dtype)
        a = jnp.einsum('td,thkd->thk', xc, u[eidx])
        hid = jax.nn.gelu(a, approximate=False) * gate
        return jnp.einsum('thk,thkd->td', hid, v[eidx])

    return lax.map(one_chunk, hc).reshape(B, S, D)


def setup_inputs(seed: int = 0) -> dict:
    key = jax.random.key(seed)
    ks = jax.random.split(key, 20)
    f32 = jnp.float32
    nrm = lambda k, shape, s: jax.random.normal(k, shape, f32) * s
    gain = lambda k, shape: 1.0 + 0.05 * jax.random.normal(k, shape, f32)
    return {
        'x': nrm(ks[0], (BATCH, SEQ, D_MODEL), 1.0),
        'p': nrm(ks[1], (DEPTH, BATCH, SEQ, PLE_DIM), 1.0),
        'g_mix': gain(ks[2], (DEPTH, D_MODEL)),
        'w_in': nrm(ks[3], (DEPTH, D_MODEL, W_IN), D_MODEL ** -0.5),
        'g_q': gain(ks[4], (DEPTH, HEAD_DIM)),
        'g_k': gain(ks[5], (DEPTH, HEAD_DIM)),
        'conv_w': nrm(ks[6], (DEPTH, CONV_K, CONV_W), CONV_K ** -0.5),
        'w_attn_out': nrm(ks[7], (DEPTH, ATTN_W, D_MODEL), ATTN_W ** -0.5),
        'w_conv_out': nrm(ks[8], (DEPTH, CONV_W, D_MODEL), CONV_W ** -0.5),
        'w_out': nrm(ks[9], (DEPTH, D_MODEL, D_MODEL), D_MODEL ** -0.5),
        'g_ffn': gain(ks[10], (DEPTH, D_MODEL)),
        'w_peer_q': nrm(ks[11], (DEPTH, D_MODEL, PEER_HEADS * PEER_DK), D_MODEL ** -0.5),
        'peer_sub_keys': nrm(ks[12], (DEPTH, PEER_HEADS, 2, PEER_N_KEYS, PEER_HALF), PEER_HALF ** -0.5),
        'peer_u': nrm(ks[13], (DEPTH, PEER_N_EXPERTS, D_MODEL), D_MODEL ** -0.5),
        'peer_v': nrm(ks[14], (DEPTH, PEER_N_EXPERTS, D_MODEL), PEER_HEADS ** -0.5),
        'g_ple': gain(ks[15], (DEPTH, D_MODEL)),
        'w_ple': nrm(ks[16], (DEPTH, PLE_DIM, D_MODEL), PLE_DIM ** -0.5),
        'w_ple_gate': nrm(ks[17], (DEPTH, D_MODEL, D_MODEL), D_MODEL ** -0.5),
    }


def reference(x, p, g_mix, w_in, g_q, g_k, conv_w, w_attn_out, w_conv_out, w_out,
              g_ffn, w_peer_q, peer_sub_keys, peer_u, peer_v, g_ple, w_ple, w_ple_gate):
    B, S, _ = x.shape
    cos, sin = axial_rope_tables(S)
    for i in range(DEPTH):
        h = rms_norm(x, g_mix[i])
        z = h @ w_in[i]
        q = z[..., OFF_Q:OFF_K].reshape(B, S, N_Q_HEADS, HEAD_DIM)
        k = z[..., OFF_K:OFF_V].reshape(B, S, N_KV_HEADS, HEAD_DIM)
        v = z[..., OFF_V:OFF_CH].reshape(B, S, N_KV_HEADS, HEAD_DIM)
        c_h = z[..., OFF_CH:OFF_CB]
        c_b = z[..., OFF_CB:OFF_CC]
        c_c = z[..., OFF_CC:OFF_GA]
        gate_a = z[..., OFF_GA:OFF_GC]
        gate_c = z[..., OFF_GC:W_IN]
        q = apply_rope(rms_norm(q, g_q[i]), cos, sin)
        k = apply_rope(rms_norm(k, g_k[i]), cos, sin)
        y_attn = block_attention(q, k, v) @ w_attn_out[i]
        y_conv = (c_b * short_conv(c_c * c_h, conv_w[i])) @ w_conv_out[i]
        merged = jax.nn.sigmoid(gate_a) * y_attn + jax.nn.sigmoid(gate_c) * y_conv
        x = x + merged @ w_out[i]
        x = x + peer(rms_norm(x, g_ffn[i]), w_peer_q[i], peer_sub_keys[i], peer_u[i], peer_v[i])
        x = x + (p[i] @ w_ple[i]) * jax.nn.sigmoid(rms_norm(x, g_ple[i]) @ w_ple_gate[i])
    return x
```

```cpp
#include <hip/hip_runtime.h>
#include <cstdio>
#include <cstdint>


#define LAS __attribute__((address_space(3)))
typedef unsigned short bf16_t;
typedef short bf16x8 __attribute__((ext_vector_type(8)));
typedef float f32x4 __attribute__((ext_vector_type(4)));
typedef float f32x2 __attribute__((ext_vector_type(2)));
typedef float f32x16 __attribute__((ext_vector_type(16)));
typedef unsigned u32x4 __attribute__((ext_vector_type(4)));
typedef unsigned u32x2 __attribute__((ext_vector_type(2)));
typedef int i32x2 __attribute__((ext_vector_type(2)));
typedef short s16x4 __attribute__((ext_vector_type(4)));
typedef int i32x4 __attribute__((ext_vector_type(4)));
typedef _Float16 h2_t __attribute__((ext_vector_type(2)));
typedef __bf16 bf16x2_t __attribute__((ext_vector_type(2)));

constexpr int T = 16384, DM = 2048, SEQ = 4096;
constexpr int OFF_Q = 0, OFF_K = 1024, OFF_V = 1280, OFF_CH = 1536, OFF_CB = 2560, OFF_CC = 3584, OFF_GA = 4608, OFF_GC = 6656, W_IN = 8704;
constexpr float EPS = 1e-6f;
constexpr int NW = 8;

constexpr size_t MiB = 1u << 20;
constexpr size_t WS_XS1 = 0;
constexpr size_t WS_XS2 = 64 * 1024;
constexpr size_t WS_SU = 192 * 1024;
constexpr size_t WS_XD = 168 * MiB;
constexpr size_t WS_SV = 128 * 1024;
constexpr size_t WS_SSQ = 1 * MiB;
constexpr size_t WS_KEYBD = 3 * MiB;
constexpr size_t WS_WPLET = 4 * MiB;
constexpr size_t WS_PB = 5 * MiB;
constexpr size_t WS_WGQ = 13 * MiB;
constexpr size_t WS_WINQ = 21 * MiB;
constexpr size_t WS_W3AT = 55 * MiB;
constexpr size_t WS_WOUTT = 63 * MiB;
constexpr size_t WS_WQP = 71 * MiB;
constexpr size_t WS_WQKT = 79 * MiB;
constexpr size_t WS_X2B = 21 * MiB;
constexpr size_t WS_UB = 87 * MiB;
constexpr size_t WS_X2Q = 119 * MiB;
constexpr size_t WS_VB = 151 * MiB;
constexpr size_t WS_XB = 215 * MiB;
constexpr size_t WS_SGA = 279 * MiB;
constexpr size_t WS_Q = 343 * MiB;
constexpr size_t WS_KV = 375 * MiB;
constexpr size_t WS_PROD = 391 * MiB;
constexpr size_t WS_CB = 423 * MiB;
constexpr size_t WS_SGC = 455 * MiB;
constexpr size_t WS_G8 = 487 * MiB;
constexpr size_t WS_MERGED = WS_Q;
constexpr size_t WS_SCORES = WS_Q;
constexpr size_t WS_CTL = 519 * MiB;
constexpr size_t CTL_BYTES = 65536;
constexpr size_t WS_CMAX = WS_CTL + 16384;
constexpr size_t WS_END = 519 * MiB + 65536;

constexpr int LDS_BYTES = 163840;

#define LDS_WAIT() asm volatile("s_waitcnt lgkmcnt(0)" ::: "memory")

__device__ __forceinline__ unsigned pkh2(float lo, float hi) { f32x2 v = {lo, hi}; h2_t b = __builtin_convertvector(v, h2_t); return __builtin_bit_cast(unsigned, b); }
__device__ __forceinline__ unsigned pk2(float lo, float hi) { f32x2 v = {lo, hi}; bf16x2_t b = __builtin_convertvector(v, bf16x2_t); return __builtin_bit_cast(unsigned, b); }
__device__ __forceinline__ float bflo(unsigned w) { return __uint_as_float(w << 16); }
__device__ __forceinline__ float bfhi(unsigned w) { return __uint_as_float(w & 0xffff0000u); }
__device__ __forceinline__ float bf2f(bf16_t h) { return __uint_as_float((unsigned)h << 16); }
__device__ __forceinline__ float sig255_(float t) { return __builtin_amdgcn_rcpf(__builtin_fmaf(__builtin_amdgcn_exp2f(t), 1.0f / 255.0f, 1.0f / 255.0f)); }
__device__ __forceinline__ float sigmoidf_(float x) { return __builtin_amdgcn_rcpf(1.0f + __builtin_amdgcn_exp2f(-1.4426950408889634f * x)); }
__device__ __forceinline__ float wave_sum(float v) {
#pragma unroll
    for (int o = 1; o < 64; o <<= 1) v += __shfl_xor(v, o);
    return v;
}

namespace pg8 {
constexpr int BM = 256, BK = 64, HALF = 128, HTB = HALF * BK * 2, STAGE_BYTES = 8 * HTB, NXCD = 8, WGM = 8;
__host__ __device__ __forceinline__ int lds_byte(int r, int c) { const int st = (r >> 4) * 2 + (c >> 5), rr = r & 15, cc = c & 31, ob = rr * 64 + cc * 2; return st * 1024 + (ob ^ (((ob >> 9) & 1) << 5)); }
__host__ __device__ __forceinline__ void stage_rc(int b, int& R, int& C) { const int st = b / 1024, sb = b % 1024, swz = sb ^ (((sb >> 9) & 1) << 5); R = (st >> 1) * 16 + swz / 64; C = (st & 1) * 32 + (swz % 64) / 2; }
__host__ __device__ __forceinline__ int perm32(int rho) { const int n = rho >> 4, i = rho & 15; return 8 * (i >> 2) + 4 * n + (i & 3); }

struct Unit { int pm, pn; };
struct Gemm { const void* A; const void* Bt; int Kb, lda_b, ldb_b, b_koff_b; };

struct StaticOrder {
    int nM, nN, nwg, G, c;
    __device__ void init(int M, int N, int G_, int c_) { nM = M / BM; nN = N / BM; nwg = nM * nN; G = G_; c = c_; }
    __device__ bool next(int i, Unit& u) const {
        const long L = (long)i * G + c; if (L >= nwg) return false;
        int wgid = (int)L; { const int q = nwg / NXCD, r = nwg % NXCD, xcd = wgid % NXCD, off = wgid / NXCD; wgid = (xcd < r ? xcd * (q + 1) : r * (q + 1) + (xcd - r) * q) + off; }
        const int nig = WGM * nN, gid = wgid / nig, fm = gid * WGM, gsz = (nM - fm) < WGM ? (nM - fm) : WGM;
        u.pm = fm + ((wgid % nig) % gsz); u.pn = (wgid % nig) / gsz; return true;
    }
};

typedef f32x4 Acc[2][2][4][2];

struct EpiBf16 {
    static constexpr bool PERM = true, HAS_MID = false;
    bf16_t* O; int ldc;
    __device__ __forceinline__ void mid(Acc& acc, const Unit& u, int wr, int wc, int fr, int fq) const {}
    __device__ __forceinline__ void operator()(Acc& acc, const Unit& u, int wr, int wc, int fr, int fq) const {
        const int row0 = u.pm * BM + wr * 64 + fr, col0 = u.pn * BM + wc * 32 + 8 * fq;
#pragma unroll
        for (int ai = 0; ai < 2; ++ai)
#pragma unroll
            for (int m = 0; m < 4; ++m) { bf16_t* rowp = O + (size_t)(row0 + ai * HALF + m * 16) * ldc + col0;
#pragma unroll
                for (int bj = 0; bj < 2; ++bj) { const f32x4 v0 = acc[ai][bj][m][0], v1 = acc[ai][bj][m][1];
                    u32x4 w; w.x = pk2(v0[0], v0[1]); w.y = pk2(v0[2], v0[3]); w.z = pk2(v1[0], v1[1]); w.w = pk2(v1[2], v1[3]);
                    *(u32x4*)(rowp + bj * HALF) = w; } }
    }
};
struct EpiF16 {
    static constexpr bool PERM = true, HAS_MID = false;
    unsigned short* O; int ldc;
    __device__ __forceinline__ void mid(Acc& acc, const Unit& u, int wr, int wc, int fr, int fq) const {}
    __device__ __forceinline__ void operator()(Acc& acc, const Unit& u, int wr, int wc, int fr, int fq) const {
        const int row0 = u.pm * BM + wr * 64 + fr, col0 = u.pn * BM + wc * 32 + 8 * fq;
#pragma unroll
        for (int ai = 0; ai < 2; ++ai)
#pragma unroll
            for (int m = 0; m < 4; ++m) { unsigned short* rowp = O + (size_t)(row0 + ai * HALF + m * 16) * ldc + col0;
#pragma unroll
                for (int bj = 0; bj < 2; ++bj) { const f32x4 v0 = acc[ai][bj][m][0], v1 = acc[ai][bj][m][1];
                    u32x4 w; w.x = pkh2(v0[0], v0[1]); w.y = pkh2(v0[2], v0[3]); w.z = pkh2(v1[0], v1[1]); w.w = pkh2(v1[2], v1[3]);
                    *(u32x4*)(rowp + bj * HALF) = w; } }
    }
};
struct EpiF32 {
    static constexpr bool PERM = false, HAS_MID = false;
    float* C; int ldc;
    __device__ __forceinline__ void mid(Acc& acc, const Unit& u, int wr, int wc, int fr, int fq) const {}
    __device__ __forceinline__ void operator()(Acc& acc, const Unit& u, int wr, int wc, int fr, int fq) const {
        const int row0 = u.pm * BM + wr * 64 + fr, col0 = u.pn * BM + wc * 32 + 4 * fq;
#pragma unroll
        for (int ai = 0; ai < 2; ++ai)
#pragma unroll
            for (int m = 0; m < 4; ++m) { float* rowp = C + (size_t)(row0 + ai * HALF + m * 16) * ldc + col0;
#pragma unroll
                for (int bj = 0; bj < 2; ++bj)
#pragma unroll
                    for (int n = 0; n < 2; ++n) *(f32x4*)(rowp + bj * HALF + n * 16) = acc[ai][bj][m][n]; }
    }
};
__device__ __forceinline__ size_t frag_off(int pm, int pn, int wr, int wc, int fr, int fq, int k) { return (size_t)(pm * 8 + pn) * 65536u + (size_t)((((k * 8 + wr * 4 + wc) * 64) + fq * 16 + fr) * 16); }
struct Epi1 {
    static constexpr bool PERM = true, HAS_MID = false;
    bf16_t *Q, *KV, *PROD, *CB; unsigned char *SGA, *SGC; const float* rstd; const float* cmax;
    __device__ __forceinline__ void mid(Acc& acc, const Unit& u, int wr, int wc, int fr, int fq) const {}
    __device__ __forceinline__ void operator()(Acc& acc, const Unit& u, int wr, int wc, int fr, int fq) const {
        const int row0 = u.pm * BM + wr * 64 + fr, cw = wc * 32 + 8 * fq, pn = u.pn;
        bf16_t* base; int ldc, col0, mode = 0;
        if (pn < 4) { base = Q; ldc = 1024; col0 = pn * 256 + cw; }
        else if (pn == 4) { base = KV; ldc = 512; col0 = cw; }
        else if (pn == 5) { base = KV; ldc = 512; col0 = 256 + cw; }
        else if (pn < 14) { base = PROD; ldc = 1024; col0 = (pn - 6) * 128 + cw; mode = 1; }
        else if (pn < 18) { base = CB; ldc = 1024; col0 = (pn - 14) * 256 + cw; }
        else if (pn < 26) { base = (bf16_t*)SGA; ldc = 1024; col0 = (pn - 18) * 256 + cw; mode = 2; }
        else { base = (bf16_t*)SGC; ldc = 1024; col0 = (pn - 26) * 256 + cw; mode = 2; }
        f32x4 cs[2][2];
#pragma unroll
        for (int bj = 0; bj < 2; ++bj)
#pragma unroll
            for (int n = 0; n < 2; ++n) cs[bj][n] = *(const f32x4*)(cmax + pn * 256 + bj * HALF + cw + 4 * n) * (1.0f / 127.0f);
#pragma unroll
        for (int ai = 0; ai < 2; ++ai)
#pragma unroll
            for (int m = 0; m < 4; ++m) { const int row = row0 + ai * HALF + m * 16; const float r = rstd[row]; bf16_t* rowp = base + (size_t)row * ldc + col0;
                if (mode == 1) {
                    const f32x4 v0 = (acc[ai][0][m][0] * cs[0][0] * r) * (acc[ai][1][m][0] * cs[1][0] * r), v1 = (acc[ai][0][m][1] * cs[0][1] * r) * (acc[ai][1][m][1] * cs[1][1] * r);
                    u32x4 w; w.x = pk2(v0[0], v0[1]); w.y = pk2(v0[2], v0[3]); w.z = pk2(v1[0], v1[1]); w.w = pk2(v1[2], v1[3]);
                    *(u32x4*)rowp = w;
                } else if (mode == 2) { u32x4 w8;
#pragma unroll
                    for (int bj = 0; bj < 2; ++bj) { const float rn = r * -1.4426950408889634f; const f32x4 v0 = acc[ai][bj][m][0] * cs[bj][0] * rn, v1 = acc[ai][bj][m][1] * cs[bj][1] * rn; unsigned q0 = 0u, q1 = 0u;
#pragma unroll
                        for (int j = 0; j < 4; ++j) { q0 = __builtin_amdgcn_cvt_pk_u8_f32(fmaxf(sig255_(v0[j]), 1.0f), j, q0); q1 = __builtin_amdgcn_cvt_pk_u8_f32(fmaxf(sig255_(v1[j]), 1.0f), j, q1); }
                        w8[2 * bj] = q0; w8[2 * bj + 1] = q1; }
                    *(u32x4*)((unsigned char*)base + frag_off(u.pm, (pn < 26) ? pn - 18 : pn - 26, wr, wc, fr, fq, ai * 4 + m)) = w8;
                } else {
#pragma unroll
                    for (int bj = 0; bj < 2; ++bj) { f32x4 v0 = acc[ai][bj][m][0] * cs[bj][0] * r, v1 = acc[ai][bj][m][1] * cs[bj][1] * r;
                        u32x4 w; w.x = pk2(v0[0], v0[1]); w.y = pk2(v0[2], v0[3]); w.z = pk2(v1[0], v1[1]); w.w = pk2(v1[2], v1[3]);
                        *(u32x4*)(rowp + bj * HALF) = w; }
                } }
    }
};
struct Epi3a {
    static constexpr bool PERM = true, HAS_MID = true;
    const unsigned char *SGA, *SGC; bf16_t* O;
    __device__ __forceinline__ void mid(Acc& acc, const Unit& u, int wr, int wc, int fr, int fq) const {
        u32x4 ga[2][4], gc[2][4];
#pragma unroll
        for (int ai = 0; ai < 2; ++ai)
#pragma unroll
            for (int m = 0; m < 4; ++m) { const size_t fo = frag_off(u.pm, u.pn, wr, wc, fr, fq, ai * 4 + m); ga[ai][m] = *(const u32x4*)(SGA + fo); gc[ai][m] = *(const u32x4*)(SGC + fo); }
#pragma unroll
        for (int ai = 0; ai < 2; ++ai)
#pragma unroll
            for (int m = 0; m < 4; ++m)
#pragma unroll
                for (int bj = 0; bj < 2; ++bj) { const unsigned ax = ga[ai][m][2 * bj], ay = ga[ai][m][2 * bj + 1], cx = gc[ai][m][2 * bj], cy = gc[ai][m][2 * bj + 1]; f32x4 r0, r1;
#pragma unroll
                    for (int j = 0; j < 4; ++j) { r0[j] = (float)((ax >> (8 * j)) & 0xffu) * __builtin_amdgcn_rcpf((float)((cx >> (8 * j)) & 0xffu)); r1[j] = (float)((ay >> (8 * j)) & 0xffu) * __builtin_amdgcn_rcpf((float)((cy >> (8 * j)) & 0xffu)); }
                    acc[ai][bj][m][0] *= r0; acc[ai][bj][m][1] *= r1; }
    }
    __device__ __forceinline__ void operator()(Acc& acc, const Unit& u, int wr, int wc, int fr, int fq) const {
        const int row0 = u.pm * BM + wr * 64 + fr, col0 = u.pn * BM + wc * 32 + 8 * fq;
        u32x4 gc[2][4];
#pragma unroll
        for (int ai = 0; ai < 2; ++ai)
#pragma unroll
            for (int m = 0; m < 4; ++m) gc[ai][m] = *(const u32x4*)(SGC + frag_off(u.pm, u.pn, wr, wc, fr, fq, ai * 4 + m));
#pragma unroll
        for (int ai = 0; ai < 2; ++ai)
#pragma unroll
            for (int m = 0; m < 4; ++m) { const size_t off = (size_t)(row0 + ai * HALF + m * 16) * DM + col0;
#pragma unroll
                for (int bj = 0; bj < 2; ++bj) { const unsigned cx = gc[ai][m][2 * bj], cy = gc[ai][m][2 * bj + 1]; const f32x4 v0 = acc[ai][bj][m][0] * (1.0f / 255.0f), v1 = acc[ai][bj][m][1] * (1.0f / 255.0f);
                    u32x4 w; w.x = pk2(v0[0] * (float)(cx & 0xffu), v0[1] * (float)((cx >> 8) & 0xffu)); w.y = pk2(v0[2] * (float)((cx >> 16) & 0xffu), v0[3] * (float)(cx >> 24));
                    w.z = pk2(v1[0] * (float)(cy & 0xffu), v1[1] * (float)((cy >> 8) & 0xffu)); w.w = pk2(v1[2] * (float)((cy >> 16) & 0xffu), v1[3] * (float)(cy >> 24));
                    *(u32x4*)(O + off + bj * HALF) = w; } }
    }
};
struct Epi3b {
    static constexpr bool PERM = true, HAS_MID = false;
    const float* X; bf16_t* XB; float* SSQ;
    __device__ __forceinline__ void mid(Acc& acc, const Unit& u, int wr, int wc, int fr, int fq) const {}
    __device__ __forceinline__ void operator()(Acc& acc, const Unit& u, int wr, int wc, int fr, int fq) const {
        const int row0 = u.pm * BM + wr * 64 + fr, col0 = u.pn * BM + wc * 32 + 8 * fq;
#pragma unroll
        for (int ai = 0; ai < 2; ++ai) {
            f32x4 xv[4][2][2];
#pragma unroll
            for (int m = 0; m < 4; ++m) { const size_t off = (size_t)(row0 + ai * HALF + m * 16) * DM + col0;
#pragma unroll
                for (int bj = 0; bj < 2; ++bj)
#pragma unroll
                    for (int n = 0; n < 2; ++n) xv[m][bj][n] = *(const f32x4*)(X + off + bj * HALF + n * 4); }
            asm volatile("" ::: "memory");
#pragma unroll
            for (int m = 0; m < 4; ++m) { const int row = row0 + ai * HALF + m * 16; const size_t off = (size_t)row * DM + col0;
#pragma unroll
                for (int bj = 0; bj < 2; ++bj) { const f32x4 o0 = xv[m][bj][0] + acc[ai][bj][m][0], o1 = xv[m][bj][1] + acc[ai][bj][m][1];
                    u32x4 w; w.x = pk2(o0[0], o0[1]); w.y = pk2(o0[2], o0[3]); w.z = pk2(o1[0], o1[1]); w.w = pk2(o1[2], o1[3]);
                    *(u32x4*)(XB + off + bj * HALF) = w;
                    } }
            asm volatile("" ::: "memory");
        }
    }
};
struct Epi8a {
    static constexpr bool PERM = true, HAS_MID = false;
    unsigned char* G; const float* rstd; const float* cmax;
    __device__ __forceinline__ void mid(Acc& acc, const Unit& u, int wr, int wc, int fr, int fq) const {}
    __device__ __forceinline__ void operator()(Acc& acc, const Unit& u, int wr, int wc, int fr, int fq) const {
        const int row0 = u.pm * BM + wr * 64 + fr, cw = wc * 32 + 8 * fq, col0 = u.pn * BM + cw;
        f32x4 cs[2][2];
#pragma unroll
        for (int bj = 0; bj < 2; ++bj)
#pragma unroll
            for (int n = 0; n < 2; ++n) cs[bj][n] = *(const f32x4*)(cmax + col0 + bj * HALF + 4 * n) * (1.0f / 127.0f);
#pragma unroll
        for (int ai = 0; ai < 2; ++ai)
#pragma unroll
            for (int m = 0; m < 4; ++m) { const int row = row0 + ai * HALF + m * 16; const float r = rstd[row];
                u32x4 w8;
#pragma unroll
                for (int bj = 0; bj < 2; ++bj) { const float rn = r * -1.4426950408889634f; const f32x4 v0 = acc[ai][bj][m][0] * cs[bj][0] * rn, v1 = acc[ai][bj][m][1] * cs[bj][1] * rn; unsigned q0 = 0u, q1 = 0u;
#pragma unroll
                    for (int j = 0; j < 4; ++j) { q0 = __builtin_amdgcn_cvt_pk_u8_f32(sig255_(v0[j]), j, q0); q1 = __builtin_amdgcn_cvt_pk_u8_f32(sig255_(v1[j]), j, q1); }
                    w8[2 * bj] = q0; w8[2 * bj + 1] = q1; }
                *(u32x4*)(G + frag_off(u.pm, u.pn, wr, wc, fr, fq, ai * 4 + m)) = w8; }
    }
};
struct Epi8b {
    static constexpr bool PERM = true, HAS_MID = false;
    float* OUT; const bf16_t* X2; const unsigned char* G;
    __device__ __forceinline__ void mid(Acc& acc, const Unit& u, int wr, int wc, int fr, int fq) const {}
    __device__ __forceinline__ void operator()(Acc& acc, const Unit& u, int wr, int wc, int fr, int fq) const {
        const int row0 = u.pm * BM + wr * 64 + fr, col0 = u.pn * BM + wc * 32 + 8 * fq;
#pragma unroll
        for (int ai = 0; ai < 2; ++ai) {
            u32x4 xq[4][2]; u32x4 gq[4];
#pragma unroll
            for (int m = 0; m < 4; ++m) { const size_t off = (size_t)(row0 + ai * HALF + m * 16) * DM + col0;
#pragma unroll
                for (int bj = 0; bj < 2; ++bj) xq[m][bj] = *(const u32x4*)(X2 + off + bj * HALF);
                gq[m] = *(const u32x4*)(G + frag_off(u.pm, u.pn, wr, wc, fr, fq, ai * 4 + m)); }
            asm volatile("" ::: "memory");
#pragma unroll
            for (int m = 0; m < 4; ++m) { const size_t off = (size_t)(row0 + ai * HALF + m * 16) * DM + col0;
#pragma unroll
                for (int bj = 0; bj < 2; ++bj) { const u32x4 xb = xq[m][bj]; u32x2 gb; gb.x = gq[m][2 * bj]; gb.y = gq[m][2 * bj + 1]; const f32x4 a0 = acc[ai][bj][m][0], a1 = acc[ai][bj][m][1]; f32x4 o0, o1;
                    o0[0] = bflo(xb.x) + a0[0] * ((float)(gb.x & 0xffu) * (1.0f / 255.0f)); o0[1] = bfhi(xb.x) + a0[1] * ((float)((gb.x >> 8) & 0xffu) * (1.0f / 255.0f));
                    o0[2] = bflo(xb.y) + a0[2] * ((float)((gb.x >> 16) & 0xffu) * (1.0f / 255.0f)); o0[3] = bfhi(xb.y) + a0[3] * ((float)(gb.x >> 24) * (1.0f / 255.0f));
                    o1[0] = bflo(xb.z) + a1[0] * ((float)(gb.y & 0xffu) * (1.0f / 255.0f)); o1[1] = bfhi(xb.z) + a1[1] * ((float)((gb.y >> 8) & 0xffu) * (1.0f / 255.0f));
                    o1[2] = bflo(xb.w) + a1[2] * ((float)((gb.y >> 16) & 0xffu) * (1.0f / 255.0f)); o1[3] = bfhi(xb.w) + a1[3] * ((float)(gb.y >> 24) * (1.0f / 255.0f));
                    *(f32x4*)(OUT + off + bj * HALF) = o0; *(f32x4*)(OUT + off + bj * HALF + 4) = o1; } }
            asm volatile("" ::: "memory");
        }
    }
};
struct Epi8 {
    static constexpr bool PERM = false, HAS_MID = false;
    float* OUT; const bf16_t* X2; const bf16_t* PE; const float* rstd; const float* cmax;
    __device__ __forceinline__ void mid(Acc& acc, const Unit& u, int wr, int wc, int fr, int fq) const {}
    __device__ __forceinline__ void operator()(Acc& acc, const Unit& u, int wr, int wc, int fr, int fq) const {
        const int row0 = u.pm * BM + wr * 64 + fr, col0 = u.pn * BM + wc * 32 + 4 * fq;
        f32x4 cs[2][2];
#pragma unroll
        for (int bj = 0; bj < 2; ++bj)
#pragma unroll
            for (int n = 0; n < 2; ++n) cs[bj][n] = *(const f32x4*)(cmax + col0 + bj * HALF + n * 16) * (1.0f / 127.0f);
#pragma unroll
        for (int ai = 0; ai < 2; ++ai) {
            u32x2 xq[4][2][2], pq[4][2][2]; float rr[4];
#pragma unroll
            for (int m = 0; m < 4; ++m) { const int row = row0 + ai * HALF + m * 16; const size_t off = (size_t)row * DM + col0; rr[m] = rstd[row];
#pragma unroll
                for (int bj = 0; bj < 2; ++bj)
#pragma unroll
                    for (int n = 0; n < 2; ++n) { const size_t o2 = off + bj * HALF + n * 16; xq[m][bj][n] = *(const u32x2*)(X2 + o2); pq[m][bj][n] = *(const u32x2*)(PE + o2); } }
            asm volatile("" ::: "memory");
#pragma unroll
            for (int m = 0; m < 4; ++m) { const int row = row0 + ai * HALF + m * 16; const size_t off = (size_t)row * DM + col0; const float r = rr[m];
#pragma unroll
                for (int bj = 0; bj < 2; ++bj)
#pragma unroll
                    for (int n = 0; n < 2; ++n) { const size_t o2 = off + bj * HALF + n * 16; const u32x2 xb2 = xq[m][bj][n], pe = pq[m][bj][n];
                        const f32x4 a = acc[ai][bj][m][n] * cs[bj][n]; f32x4 o;
                        o[0] = bflo(xb2.x) + bflo(pe.x) * sigmoidf_(r * a[0]); o[1] = bfhi(xb2.x) + bfhi(pe.x) * sigmoidf_(r * a[1]);
                        o[2] = bflo(xb2.y) + bflo(pe.y) * sigmoidf_(r * a[2]); o[3] = bfhi(xb2.y) + bfhi(pe.y) * sigmoidf_(r * a[3]);
                        *(f32x4*)(OUT + o2) = o; } }
            asm volatile("" ::: "memory");
        }
    }
};

template <class Epi, class Sched, bool I8 = false>
__device__ __forceinline__ void gemm_phase(LAS unsigned char* lds, const Gemm g, const Sched& S, const Epi& E, const int tid, const int wid) {
    const int lane = tid & 63, wr = wid >> 2, wc = wid & 3, fr = lane & 15, fq = lane >> 4;
    int K_ = g.Kb; asm volatile("" : "+s"(K_));
    const int nt = K_ / (BK * 2);
    unsigned voffA[2], voffB[2];
#pragma unroll
    for (int i = 0; i < 2; ++i) { int R, C; stage_rc(tid * 16 + i * 8192, R, C); const int Rb = Epi::PERM ? ((R & ~31) + perm32(R & 31)) : R;
        voffA[i] = (unsigned)(R * g.lda_b + C * 2); voffB[i] = (unsigned)(Rb * g.ldb_b + C * 2); }
    const size_t kstep = (size_t)(BK * 2);
    const size_t hstepA = (size_t)HALF * g.lda_b, hstepB = (size_t)HALF * g.ldb_b;
    const size_t tstepA = 2 * hstepA, tstepB = 2 * hstepB;
    const unsigned ldsw = (unsigned)wid * 1024u;
    const int aoff = lds_byte(wr * 64 + fr, fq * 8), boff = lds_byte(wc * 32 + fr, fq * 8);
#define PG8_SA(b, h) (((b) * 2 + (h)) * HTB)
#define PG8_SB(b, h) ((4 + (b) * 2 + (h)) * HTB)
#define PG8_STAGE(bufoff, gbase, voff) do { _Pragma("unroll") for (int _i = 0; _i < 2; ++_i) \
        __builtin_amdgcn_global_load_lds((const unsigned*)((const char*)(gbase) + (voff)[_i]), (LAS unsigned*)(lds + (bufoff) + ldsw + _i * 8192), 16, 0, 0); } while (0)
#define PG8_LDA(dst, b, h) do { _Pragma("unroll") for (int m = 0; m < 4; ++m) _Pragma("unroll") for (int k = 0; k < 2; ++k) dst[m][k] = *(const LAS bf16x8*)(lds + PG8_SA(b, h) + aoff + m * 2048 + k * 1024); } while (0)
#define PG8_LDB(dst, b, h) do { _Pragma("unroll") for (int n = 0; n < 2; ++n) _Pragma("unroll") for (int k = 0; k < 2; ++k) dst[n][k] = *(const LAS bf16x8*)(lds + PG8_SB(b, h) + boff + n * 2048 + k * 1024); } while (0)
#define PG8_MMA(ai, bj, At, Bt) do { __builtin_amdgcn_s_setprio(1); _Pragma("unroll") for (int m = 0; m < 4; ++m) _Pragma("unroll") for (int n = 0; n < 2; ++n) _Pragma("unroll") for (int k = 0; k < 2; ++k) { \
        if constexpr (I8) acc[ai][bj][m][n] = __builtin_bit_cast(f32x4, __builtin_amdgcn_mfma_i32_16x16x64_i8(__builtin_bit_cast(i32x4, Bt[n][k]), __builtin_bit_cast(i32x4, At[m][k]), __builtin_bit_cast(i32x4, acc[ai][bj][m][n]), 0, 0, 0)); \
        else acc[ai][bj][m][n] = __builtin_amdgcn_mfma_f32_16x16x32_bf16(Bt[n][k], At[m][k], acc[ai][bj][m][n], 0, 0, 0); } __builtin_amdgcn_s_setprio(0); } while (0)
#define PG8_WAIT_V(n) asm volatile("s_waitcnt vmcnt(" #n ")" ::: "memory")
#define PG8_WAIT_L(n) asm volatile("s_waitcnt lgkmcnt(" #n ")" ::: "memory")
#define PG8_BAR __builtin_amdgcn_s_barrier()
#define PG8_SCHED __builtin_amdgcn_sched_barrier(0)
#define PG8_BASEA(u) ((const char*)g.A + (size_t)(u).pm * tstepA)
#define PG8_BASEB(u) ((const char*)g.Bt + (size_t)(u).pn * tstepB + (size_t)(u).pm * (size_t)g.b_koff_b)
    Unit cur, nxt; int ui = 0;
    if (!S.next(0, cur)) return;
    Acc acc;
#pragma unroll
    for (int a = 0; a < 2; ++a)
#pragma unroll
        for (int b = 0; b < 2; ++b)
#pragma unroll
            for (int m = 0; m < 4; ++m)
#pragma unroll
                for (int n = 0; n < 2; ++n) acc[a][b][m][n] = (f32x4){0.f, 0.f, 0.f, 0.f};
    bf16x8 At[4][2], B0[2][2], B1[2][2];
    const char* cA = PG8_BASEA(cur); const char* cB = PG8_BASEB(cur);
    PG8_STAGE(PG8_SB(0, 0), cB, voffB); PG8_STAGE(PG8_SB(0, 1), cB + hstepB, voffB); PG8_STAGE(PG8_SA(0, 0), cA, voffA); PG8_STAGE(PG8_SA(0, 1), cA + hstepA, voffA);
    if (wr == 1) PG8_BAR;
    PG8_WAIT_V(2); PG8_BAR;
    PG8_STAGE(PG8_SB(1, 0), cB + kstep, voffB); PG8_STAGE(PG8_SA(1, 0), cA + kstep, voffA); PG8_STAGE(PG8_SB(1, 1), cB + hstepB + kstep, voffB);
    PG8_WAIT_V(6); PG8_BAR;
    for (;;) {
        const bool has_next = S.next(ui + 1, nxt);
        const char* nA = has_next ? PG8_BASEA(nxt) : cA; const char* nB = has_next ? PG8_BASEB(nxt) : cB;
        for (int t = 0; t < nt; t += 2) {
            if constexpr (Epi::HAS_MID) { if (t == (nt >> 1)) { int fq_ = fq; asm volatile("" : "+v"(fq_)); E.mid(acc, cur, wr, wc, fr, fq_); } }
            const bool last = (t == nt - 2);
            const char* a1 = cA + (size_t)(t + 1) * kstep;
            const char* a2 = last ? nA : cA + (size_t)(t + 2) * kstep; const char* b2 = last ? nB : cB + (size_t)(t + 2) * kstep;
            const char* a3 = a2 + kstep; const char* b3 = b2 + kstep;
            PG8_LDB(B0, 0, 0); PG8_LDB(B1, 0, 1); PG8_SCHED; PG8_LDA(At, 0, 0); PG8_STAGE(PG8_SA(1, 1), a1 + hstepA, voffA);
            PG8_WAIT_V(8); PG8_WAIT_L(0); PG8_BAR; PG8_MMA(0, 0, At, B0); PG8_MMA(0, 1, At, B1); PG8_BAR; PG8_SCHED;
            PG8_LDA(At, 0, 1); PG8_STAGE(PG8_SB(0, 0), b2, voffB); PG8_STAGE(PG8_SB(0, 1), b2 + hstepB, voffB); PG8_STAGE(PG8_SA(0, 0), a2, voffA);
            PG8_WAIT_V(8); PG8_WAIT_L(0); PG8_BAR; PG8_MMA(1, 0, At, B0); PG8_MMA(1, 1, At, B1); PG8_BAR; PG8_SCHED;
            PG8_LDB(B0, 1, 0); PG8_LDB(B1, 1, 1); PG8_SCHED; PG8_LDA(At, 1, 0); PG8_STAGE(PG8_SA(0, 1), a2 + hstepA, voffA);
            PG8_WAIT_V(8); PG8_WAIT_L(0); PG8_BAR; PG8_MMA(0, 0, At, B0); PG8_MMA(0, 1, At, B1); PG8_BAR; PG8_SCHED;
            PG8_LDA(At, 1, 1); PG8_STAGE(PG8_SB(1, 0), b3, voffB); PG8_STAGE(PG8_SB(1, 1), b3 + hstepB, voffB); PG8_STAGE(PG8_SA(1, 0), a3, voffA);
            PG8_WAIT_V(8); PG8_WAIT_L(0); PG8_BAR; PG8_MMA(1, 0, At, B0); PG8_MMA(1, 1, At, B1); PG8_BAR; PG8_SCHED;
        }
        if (wr == 0) PG8_BAR;
        if constexpr (I8) {
#pragma unroll
            for (int a = 0; a < 2; ++a)
#pragma unroll
                for (int b = 0; b < 2; ++b)
#pragma unroll
                    for (int m = 0; m < 4; ++m)
#pragma unroll
                        for (int n = 0; n < 2; ++n) { const i32x4 iv = __builtin_bit_cast(i32x4, acc[a][b][m][n]); acc[a][b][m][n] = (f32x4){(float)iv[0], (float)iv[1], (float)iv[2], (float)iv[3]}; } }
        { int fq_ = fq; asm volatile("" : "+v"(fq_)); E(acc, cur, wr, wc, fr, fq_); }
        if (!has_next) break;
#pragma unroll
        for (int a = 0; a < 2; ++a)
#pragma unroll
            for (int b = 0; b < 2; ++b)
#pragma unroll
                for (int m = 0; m < 4; ++m)
#pragma unroll
                    for (int n = 0; n < 2; ++n) acc[a][b][m][n] = (f32x4){0.f, 0.f, 0.f, 0.f};
        cur = nxt; cA = nA; cB = nB; ++ui;
        if (wr == 1) PG8_BAR;
    }
    PG8_WAIT_V(0);
    PG8_BAR;
#undef PG8_SA
#undef PG8_SB
#undef PG8_STAGE
#undef PG8_LDA
#undef PG8_LDB
#undef PG8_MMA
#undef PG8_WAIT_V
#undef PG8_WAIT_L
#undef PG8_BAR
#undef PG8_SCHED
#undef PG8_BASEA
#undef PG8_BASEB
}
}

namespace attn {
constexpr int D = 128, QBLK = 32, KVBLK = 64;
constexpr float SCALE = 0.088388347648318440f;
constexpr float THR = 8.f;
constexpr int LDQ = 1024, LDK = 512, LDO = 2048;
constexpr size_t SHM_V = KVBLK * D * 2, SHM_K = KVBLK * D * 2, SHM_ATTN = 2 * SHM_V + 2 * SHM_K + NW * 64 * 4;
#define KSWZ(row, colB) ((row) * 256 + ((colB) ^ (((row) & 7) << 4)))
#define SBAR() __builtin_amdgcn_sched_barrier(0)
__device__ __forceinline__ int crow(int r, int hi) { return (r & 3) + 8 * (r >> 2) + 4 * hi; }
__device__ __forceinline__ unsigned cvtpk(float lo, float hi) { unsigned r; asm volatile("v_cvt_pk_bf16_f32 %0, %1, %2" : "=v"(r) : "v"(lo), "v"(hi)); return r; }
__device__ __forceinline__ bf16x8 ld8(const bf16_t* p) { return *reinterpret_cast<const bf16x8*>(p); }

__device__ __forceinline__ void partialSM(f32x16& p0, f32x16& p1, float& m_reg, float& mn, float& alpha) {
  constexpr float C = SCALE * 1.4426950408889634f;
  float pmax = p0[0];
#pragma unroll
  for (int r = 1; r < 16; ++r) pmax = fmaxf(pmax, p0[r]);
#pragma unroll
  for (int r = 0; r < 16; ++r) pmax = fmaxf(pmax, p1[r]);
  { auto rr = __builtin_amdgcn_permlane32_swap(__float_as_uint(pmax), __float_as_uint(pmax), false, false);
    pmax = fmaxf(__uint_as_float(rr[0]), __uint_as_float(rr[1])); }
  if (__builtin_expect(__all(pmax - m_reg <= THR / SCALE), 1)) { mn = m_reg; alpha = 1.f; }
  else { mn = fmaxf(m_reg, pmax); alpha = __builtin_amdgcn_exp2f((m_reg - mn) * C); m_reg = mn; }
  float mnC = -mn * C;
#pragma unroll
  for (int r = 0; r < 16; ++r) p0[r] = fmaf(p0[r], C, mnC);
#pragma unroll
  for (int r = 0; r < 16; ++r) p1[r] = fmaf(p1[r], C, mnC);
#pragma unroll
  for (int r = 0; r < 16; ++r) p0[r] = __builtin_amdgcn_exp2f(p0[r]);
}
__device__ __forceinline__ void finishSM(f32x16& p0, f32x16& p1, float alpha, float& l_reg, bf16x8& pa0, bf16x8& pa1, bf16x8& pa2, bf16x8& pa3) {
#pragma unroll
  for (int r = 0; r < 16; ++r) p1[r] = __builtin_amdgcn_exp2f(p1[r]);
  float ps = 0;
#pragma unroll
  for (int r = 0; r < 16; ++r) ps += p0[r];
#pragma unroll
  for (int r = 0; r < 16; ++r) ps += p1[r];
  { auto rr = __builtin_amdgcn_permlane32_swap(__float_as_uint(ps), __float_as_uint(ps), false, false);
    ps = __uint_as_float(rr[0]) + __uint_as_float(rr[1]); }
  l_reg = l_reg * alpha + ps;
#define PK4(P, BASE, OUT) do { unsigned a0 = cvtpk(P[BASE + 0], P[BASE + 1]), a1 = cvtpk(P[BASE + 2], P[BASE + 3]);   \
    unsigned b0 = cvtpk(P[BASE + 4], P[BASE + 5]), b1 = cvtpk(P[BASE + 6], P[BASE + 7]);                              \
    auto r0 = __builtin_amdgcn_permlane32_swap(a0, b0, false, false); auto r1 = __builtin_amdgcn_permlane32_swap(a1, b1, false, false); \
    u32x4 w = {r0[0], r1[0], r0[1], r1[1]}; OUT = *reinterpret_cast<bf16x8*>(&w); } while (0)
  PK4(p0, 0, pa0); PK4(p0, 8, pa1); PK4(p1, 0, pa2); PK4(p1, 8, pa3);
#undef PK4
}
__device__ __forceinline__ void qkt(f32x16& p0, f32x16& p1, const bf16_t* Ks, const bf16x8* qr, int r32, int hi) {
  p0 = f32x16{}; p1 = f32x16{};
#pragma unroll
  for (int d0 = 0; d0 < 8; ++d0) { int cb = (d0 * 16 + hi * 8) * 2;
    bf16x8 b0 = *reinterpret_cast<const bf16x8*>((const char*)Ks + KSWZ(r32, cb));
    bf16x8 b1 = *reinterpret_cast<const bf16x8*>((const char*)Ks + KSWZ(32 + r32, cb));
    p0 = __builtin_amdgcn_mfma_f32_32x32x16_bf16(b0, qr[d0], p0, 0, 0, 0);
    p1 = __builtin_amdgcn_mfma_f32_32x32x16_bf16(b1, qr[d0], p1, 0, 0, 0); }
}
__device__ __forceinline__ int v_st(int k, int c) { const int kk = (k & ~0xC) | ((k & 4) << 1) | ((k & 8) >> 1); return ((kk >> 3) * 4 + (c >> 5)) * 512 + ((kk & 7) * 32 + (c & 31)) * 2; }
__device__ __forceinline__ int v_rd_base(int lane) { return ((lane & 3) << 3) | (((lane >> 2) & 3) << 6) | (((lane >> 4) & 1) << 5) | (((lane >> 5) & 1) << 8); }
constexpr int v_rd_off(int d0, int ks, int half) { return d0 * 512 + ks * 4096 + half * 2048; }
template <int OFF> __device__ __forceinline__ s16x4 tr_read(int vb) {
  s16x4 r; asm volatile("ds_read_b64_tr_b16 %0, %1 offset:%2" : "=&v"(r) : "v"(vb), "i"(OFF) : "memory"); return r;
}
template <int D0> __device__ __forceinline__ void pv_one(f32x16& od, int vb, bf16x8 pa0, bf16x8 pa1, bf16x8 pa2, bf16x8 pa3) {
  const s16x4 l0 = tr_read<v_rd_off(D0, 0, 0)>(vb), h0 = tr_read<v_rd_off(D0, 0, 1)>(vb), l1 = tr_read<v_rd_off(D0, 1, 0)>(vb), h1 = tr_read<v_rd_off(D0, 1, 1)>(vb);
  const s16x4 l2 = tr_read<v_rd_off(D0, 2, 0)>(vb), h2 = tr_read<v_rd_off(D0, 2, 1)>(vb), l3 = tr_read<v_rd_off(D0, 3, 0)>(vb), h3 = tr_read<v_rd_off(D0, 3, 1)>(vb);
  asm volatile("s_waitcnt lgkmcnt(0)" ::: "memory"); SBAR();
#define PK(L, H) (bf16x8){L[0], L[1], L[2], L[3], H[0], H[1], H[2], H[3]}
  od = __builtin_amdgcn_mfma_f32_32x32x16_bf16(pa0, PK(l0, h0), od, 0, 0, 0);
  od = __builtin_amdgcn_mfma_f32_32x32x16_bf16(pa1, PK(l1, h1), od, 0, 0, 0);
  od = __builtin_amdgcn_mfma_f32_32x32x16_bf16(pa2, PK(l2, h2), od, 0, 0, 0);
  od = __builtin_amdgcn_mfma_f32_32x32x16_bf16(pa3, PK(l3, h3), od, 0, 0, 0);
#undef PK
}
__device__ __forceinline__ void pv_d0(f32x16* o, int vb, bf16x8 pa0, bf16x8 pa1, bf16x8 pa2, bf16x8 pa3) {
  pv_one<0>(o[0], vb, pa0, pa1, pa2, pa3); pv_one<1>(o[1], vb, pa0, pa1, pa2, pa3); pv_one<2>(o[2], vb, pa0, pa1, pa2, pa3); pv_one<3>(o[3], vb, pa0, pa1, pa2, pa3);
}
__device__ __forceinline__ void attn_dense_body(const bf16_t* __restrict__ Qb, const bf16_t* __restrict__ Kh, const bf16_t* __restrict__ Vh,
                                                bf16_t* __restrict__ Ob, int seq, char* lds, const int tid, const int wid) {
  const int lane = tid & 63, r32 = lane & 31, hi = lane >> 5;
  bf16_t* V_lds = (bf16_t*)lds; bf16_t* K_lds = (bf16_t*)(lds + 2 * SHM_V);
  float* ws = (float*)(lds + 2 * SHM_V + 2 * SHM_K) + wid * 64; float* li_l = ws; float* al_l = ws + 32;
  float m_reg = -1e30f, l_reg = 0; f32x16 o[4] = {}; bf16x8 qr[8];
  const bf16_t* Qw = Qb + (long)(wid * QBLK + r32) * LDQ + hi * 8;
#pragma unroll
  for (int d0 = 0; d0 < 8; ++d0) qr[d0] = ld8(Qw + d0 * 16);
  const int sr = tid >> 4, sc = (tid & 15) * 8, vst0 = v_st(sr, sc), vst1 = v_st(32 + sr, sc);
  const int vb0 = (int)(uintptr_t)V_lds + v_rd_base(lane);
  struct { bf16x8 vs0, vs1, ks0, ks1; } sr_[2];
#define SLOAD(i, k0) do { sr_[i].vs0 = ld8(&Vh[(long)((k0) + sr) * LDK + sc]); sr_[i].vs1 = ld8(&Vh[(long)((k0) + 32 + sr) * LDK + sc]); \
    sr_[i].ks0 = ld8(&Kh[(long)((k0) + sr) * LDK + sc]); sr_[i].ks1 = ld8(&Kh[(long)((k0) + 32 + sr) * LDK + sc]); } while (0)
#define SWRITE(b, i) do { *(bf16x8*)((char*)V_lds + (b) * SHM_V + vst0) = sr_[i].vs0;          \
    *(bf16x8*)((char*)V_lds + (b) * SHM_V + vst1) = sr_[i].vs1; int kc = sc * 2;               \
    *(bf16x8*)((char*)K_lds + (b) * SHM_K + KSWZ(sr, kc)) = sr_[i].ks0;                       \
    *(bf16x8*)((char*)K_lds + (b) * SHM_K + KSWZ(32 + sr, kc)) = sr_[i].ks1; } while (0)
#define SWAIT() asm volatile("s_waitcnt vmcnt(4)" ::: "memory")
#define RESC(a) do { if (__any((a) < 1.f)) { if (hi == 0) al_l[r32] = (a); asm volatile("s_waitcnt lgkmcnt(0)" ::: "memory"); \
    _Pragma("unroll") for (int d = 0; d < 4; ++d) _Pragma("unroll") for (int r = 0; r < 16; ++r) o[d][r] *= al_l[crow(r, hi)]; } } while (0)
  f32x16 pA0, pA1, pB0, pB1; float mnA, mnB, alA, alB; bf16x8 pa0, pa1, pa2, pa3; const int NT = seq / KVBLK;
  constexpr int SE = 0, SO = 1;
  SLOAD(SE, 0); asm volatile("s_waitcnt vmcnt(0)" ::: "memory"); SWRITE(0, SE); __syncthreads();
  qkt(pA0, pA1, K_lds, qr, r32, hi); partialSM(pA0, pA1, m_reg, mnA, alA);
  SLOAD(SO, KVBLK); if (2 < NT) SLOAD(SE, 2 * KVBLK);
  SWAIT(); SWRITE(1, SO); __syncthreads();
  for (int j = 1; j + 1 < NT; j += 2) {
    SBAR(); qkt(pB0, pB1, (bf16_t*)((char*)K_lds + SHM_K), qr, r32, hi);
    finishSM(pA0, pA1, alA, l_reg, pa0, pa1, pa2, pa3); SBAR();
    SLOAD(SO, (j + 2) * KVBLK); SBAR();
    pv_d0(o, vb0, pa0, pa1, pa2, pa3); partialSM(pB0, pB1, m_reg, mnB, alB);
    __syncthreads(); SWAIT(); SWRITE(0, SE);
    RESC(alB); __syncthreads();
    SBAR(); qkt(pA0, pA1, K_lds, qr, r32, hi);
    finishSM(pB0, pB1, alB, l_reg, pa0, pa1, pa2, pa3); SBAR();
    if (j + 3 < NT) SLOAD(SE, (j + 3) * KVBLK); SBAR();
    pv_d0(o, vb0 + (int)SHM_V, pa0, pa1, pa2, pa3); partialSM(pA0, pA1, m_reg, mnA, alA);
    __syncthreads(); SWAIT(); SWRITE(1, SO);
    RESC(alA); __syncthreads();
  }
  SBAR(); qkt(pB0, pB1, (bf16_t*)((char*)K_lds + SHM_K), qr, r32, hi);
  finishSM(pA0, pA1, alA, l_reg, pa0, pa1, pa2, pa3); SBAR();
  pv_d0(o, vb0, pa0, pa1, pa2, pa3); partialSM(pB0, pB1, m_reg, mnB, alB);
  __syncthreads(); RESC(alB);
  finishSM(pB0, pB1, alB, l_reg, pa0, pa1, pa2, pa3); SBAR();
  pv_d0(o, vb0 + (int)SHM_V, pa0, pa1, pa2, pa3);
  if (hi == 0) li_l[r32] = l_reg; asm volatile("s_waitcnt lgkmcnt(0)" ::: "memory");
  float rli[16];
#pragma unroll
  for (int r = 0; r < 16; ++r) rli[r] = __builtin_amdgcn_rcpf(li_l[crow(r, hi)]);
  bf16_t* Ow = Ob + (long)(wid * QBLK) * LDO;
#pragma unroll
  for (int r = 0; r < 16; ++r) { int orow = crow(r, hi);
#pragma unroll
    for (int d0 = 0; d0 < 4; ++d0) Ow[(long)orow * LDO + d0 * 32 + r32] = (bf16_t)(pk2(o[d0][r] * rli[r], 0.f) & 0xffffu); }
#undef SLOAD
#undef SWRITE
#undef SWAIT
#undef RESC
}
#undef KSWZ
#undef SBAR
}

__device__ __forceinline__ unsigned f2ord(float f) { const unsigned u = __float_as_uint(f); return u ^ ((unsigned)((int)u >> 31) | 0x80000000u); }
__device__ __forceinline__ float ord2f(unsigned k) { const unsigned u = (k & 0x80000000u) ? (k & 0x7fffffffu) : ~k; return __uint_as_float(u); }
template <int CTRL> __device__ __forceinline__ unsigned dppu(unsigned v) { return (unsigned)__builtin_amdgcn_update_dpp(0, (int)v, CTRL, 0xF, 0xF, false); }
template <int CTRL> __device__ __forceinline__ float dppf(float v) { return __int_as_float(__builtin_amdgcn_update_dpp(0, __float_as_int(v), CTRL, 0xF, 0xF, false)); }
constexpr int DPP_X1 = 0xB1, DPP_X2 = 0x4E, DPP_HMIR = 0x141, DPP_MIR = 0x140;
__device__ __forceinline__ unsigned umax_(unsigned a, unsigned b) { return a > b ? a : b; }
__device__ __forceinline__ unsigned umin_(unsigned a, unsigned b) { return a < b ? a : b; }
template <int N> __device__ __forceinline__ void bitonic_sort_desc(unsigned (&k)[N]) {
#pragma unroll
    for (int size = 2; size <= N; size <<= 1) {
#pragma unroll
        for (int stride = size >> 1; stride > 0; stride >>= 1) {
#pragma unroll
            for (int i = 0; i < N; ++i) { const int j = i ^ stride;
                if (j > i) { const bool desc = ((i & size) == 0) || (size == N); const unsigned a = k[i], b = k[j], mx = umax_(a, b), mn = umin_(a, b); k[i] = desc ? mx : mn; k[j] = desc ? mn : mx; } }
        }
    }
}
__device__ __forceinline__ void sort16_desc(unsigned (&k)[16]) {
    constexpr int P[63][2] = {{0, 1}, {2, 3}, {0, 2}, {1, 3}, {1, 2}, {4, 5}, {6, 7}, {4, 6}, {5, 7}, {5, 6}, {0, 4}, {2, 6}, {2, 4}, {1, 5}, {3, 7}, {3, 5}, {1, 2}, {3, 4}, {5, 6}, {8, 9}, {10, 11}, {8, 10}, {9, 11}, {9, 10}, {12, 13}, {14, 15}, {12, 14}, {13, 15}, {13, 14}, {8, 12}, {10, 14}, {10, 12}, {9, 13}, {11, 15}, {11, 13}, {9, 10}, {11, 12}, {13, 14}, {0, 8}, {4, 12}, {4, 8}, {2, 10}, {6, 14}, {6, 10}, {2, 4}, {6, 8}, {10, 12}, {1, 9}, {5, 13}, {5, 9}, {3, 11}, {7, 15}, {7, 11}, {3, 5}, {7, 9}, {11, 13}, {1, 2}, {3, 4}, {5, 6}, {7, 8}, {9, 10}, {11, 12}, {13, 14}};
#pragma unroll
    for (int c = 0; c < 63; ++c) { const unsigned a = k[P[c][0]], b = k[P[c][1]]; k[P[c][0]] = umax_(a, b); k[P[c][1]] = umin_(a, b); }
}
typedef short s16x2_t __attribute__((ext_vector_type(2)));
__device__ __forceinline__ unsigned h2ord2(unsigned w) { const s16x2_t m = __builtin_bit_cast(s16x2_t, w) >> 15; return w ^ (__builtin_bit_cast(unsigned, m) | 0x80008000u); }
__device__ __forceinline__ float okey2f(unsigned k) { unsigned h = k >> 16; h ^= ((int)k < 0) ? 0x8000u : 0xFFFFu; return (float)__builtin_bit_cast(_Float16, (unsigned short)h); }
template <int N> __device__ __forceinline__ void bitonic_merge_desc(unsigned (&k)[N]) {
#pragma unroll
    for (int stride = N >> 1; stride > 0; stride >>= 1) {
#pragma unroll
        for (int i = 0; i < N; ++i) { const int j = i ^ stride; if (j > i) { const unsigned a = k[i], b = k[j]; k[i] = umax_(a, b); k[j] = umin_(a, b); } }
    }
}
__device__ __forceinline__ float dot2bf(unsigned w, unsigned x, float acc) { return __builtin_amdgcn_fdot2_f32_bf16(__builtin_bit_cast(bf16x2_t, w), __builtin_bit_cast(bf16x2_t, x), acc, false); }
__device__ __forceinline__ float wave_sum_dpp(float v) {
    v += dppf<DPP_X1>(v); v += dppf<DPP_X2>(v); v += dppf<DPP_HMIR>(v); v += dppf<DPP_MIR>(v);
    return (__int_as_float(__builtin_amdgcn_readlane(__float_as_int(v), 0)) + __int_as_float(__builtin_amdgcn_readlane(__float_as_int(v), 16))) +
           (__int_as_float(__builtin_amdgcn_readlane(__float_as_int(v), 32)) + __int_as_float(__builtin_amdgcn_readlane(__float_as_int(v), 48)));
}

__device__ __forceinline__ int win_src_col(int r) {
    const int tile = r >> 8, w = r & 255;
    if (tile < 4) return OFF_Q + r;
    if (tile == 4) return OFF_K + w;
    if (tile == 5) return OFF_V + w;
    if (tile < 14) { const int j = tile - 6; return (w < 128) ? (OFF_CH + j * 128 + w) : (OFF_CC + j * 128 + (w - 128)); }
    if (tile < 18) return OFF_CB + (r - 14 * 256);
    if (tile < 26) return OFF_GA + (r - 18 * 256);
    return OFF_GC + (r - 26 * 256);
}
__device__ __forceinline__ void transpose_item(const float* __restrict__ W, int ldw, int k0, int nsrc0, bf16_t* WT, int ldd, int drow0, int dcol0, const float* g, LAS float* scr, int lane) {
    { float v[32]; const float* wp = W + (size_t)(k0 + (lane >> 5)) * ldw + nsrc0 + (lane & 31);
#pragma unroll
      for (int i = 0; i < 32; ++i) v[i] = wp[(size_t)(2 * i) * ldw];
      if (g) {
#pragma unroll
          for (int i = 0; i < 32; ++i) v[i] *= g[k0 + 2 * i + (lane >> 5)]; }
#pragma unroll
      for (int i = 0; i < 32; ++i) scr[(2 * i + (lane >> 5)) * 33 + (lane & 31)] = v[i]; }
    LDS_WAIT();
    const int c = lane & 7;
#pragma unroll
    for (int j = 0; j < 4; ++j) { const int n = (lane >> 3) + 8 * j; const LAS float* s = scr + (8 * c) * 33 + n;
        u32x4 o; o.x = pk2(s[0 * 33], s[1 * 33]); o.y = pk2(s[2 * 33], s[3 * 33]); o.z = pk2(s[4 * 33], s[5 * 33]); o.w = pk2(s[6 * 33], s[7 * 33]);
        *(u32x4*)(WT + (size_t)(drow0 + n) * ldd + dcol0 + 8 * c) = o; }
    LDS_WAIT();
}


__device__ __forceinline__ unsigned q8(float v) { return (unsigned)__float2int_rn(fminf(fmaxf(v, -127.0f), 127.0f)) & 0xffu; }
__device__ __forceinline__ unsigned q8x4(float a, float b, float c, float d) { return q8(a) | (q8(b) << 8) | (q8(c) << 16) | (q8(d) << 24); }
__device__ __forceinline__ void colmax_item(const float* __restrict__ W, int ldw, int k0, int nsrc0, const float* g, unsigned* cmax, int drow0, int lane) {
    float m = 0.f;
    { float v[32]; const float* wp = W + (size_t)(k0 + (lane >> 5)) * ldw + nsrc0 + (lane & 31);
#pragma unroll
      for (int i = 0; i < 32; ++i) v[i] = wp[(size_t)(2 * i) * ldw];
#pragma unroll
      for (int i = 0; i < 32; ++i) m = fmaxf(m, fabsf(v[i] * g[k0 + 2 * i + (lane >> 5)])); }
    m = fmaxf(m, __shfl_xor(m, 32));
    if (lane < 32) atomicMax(cmax + drow0 + lane, __float_as_uint(m));
}
__device__ __forceinline__ void quant_transpose_item(const float* __restrict__ W, int ldw, int k0, int nsrc0, unsigned char* WT, int ldd_b, int drow0, int dcol0, const float* g, unsigned* cmax, LAS float* scr, int lane) {
    { float v[32]; const float* wp = W + (size_t)(k0 + (lane >> 5)) * ldw + nsrc0 + (lane & 31);
#pragma unroll
      for (int i = 0; i < 32; ++i) v[i] = wp[(size_t)(2 * i) * ldw];
#pragma unroll
      for (int i = 0; i < 32; ++i) scr[(2 * i + (lane >> 5)) * 33 + (lane & 31)] = v[i] * g[k0 + 2 * i + (lane >> 5)]; }
    LDS_WAIT();
#pragma unroll
    for (int j = 0; j < 2; ++j) { const int p = lane + 64 * j, n = p >> 2, c4 = p & 3;
        const float cm = __uint_as_float(__hip_atomic_load(cmax + drow0 + n, __ATOMIC_RELAXED, __HIP_MEMORY_SCOPE_AGENT)); const float sc = cm > 0.f ? 127.0f / cm : 0.f;
        const LAS float* sp = scr + (16 * c4) * 33 + n; u32x4 o;
#pragma unroll
        for (int q = 0; q < 4; ++q) o[q] = q8x4(sp[(4 * q) * 33] * sc, sp[(4 * q + 1) * 33] * sc, sp[(4 * q + 2) * 33] * sc, sp[(4 * q + 3) * 33] * sc);
        *(u32x4*)(WT + (size_t)(drow0 + n) * ldd_b + dcol0 + 16 * c4) = o; }
    LDS_WAIT();
}

#define XB_TMO      128
#define XB_XCNT(j)  (256  + 64 * (j))
#define XB_XSUB(j)  (1280 + 64 * (j))
#define XB_XGEN(j)  (2304 + 64 * (j))
#define XB_TOP      3328
#define XB_TOPGEN   3392
#define XCD_BAR_WORDS 3456
#define XB_SPIN_CAP (1u << 18)
__device__ __forceinline__ unsigned xb_ld(unsigned* p)              { return __hip_atomic_load(p, __ATOMIC_RELAXED, __HIP_MEMORY_SCOPE_AGENT); }
__device__ __forceinline__ unsigned xb_add(unsigned* p, unsigned v) { return __hip_atomic_fetch_add(p, v, __ATOMIC_RELAXED, __HIP_MEMORY_SCOPE_AGENT); }
__device__ __forceinline__ unsigned xb_xcc_id() { return (unsigned)__builtin_amdgcn_s_getreg((3 << 11) | 20) & 0xFu; }
#define XB_SPIN(cond, bar) do { unsigned _sp = 0; while (cond) { __builtin_amdgcn_s_sleep(1); \
    if ((++_sp & 255u) == 0u) { if (xb_ld(&(bar)[XB_TMO])) break; if (_sp > XB_SPIN_CAP) { atomicAdd(&(bar)[XB_TMO], 1u); break; } } } } while (0)
__device__ __forceinline__ void xcd_barrier_complete(unsigned* bar, unsigned x, unsigned& nloc, unsigned& nx) {
    const unsigned G = gridDim.x;
    unsigned sum, cnt, mine, sp = 0u;
    for (;;) {
        sum = 0u; cnt = 0u; mine = 0u;
#pragma unroll
        for (unsigned j = 0; j < 16; ++j) { const unsigned c = xb_ld(&bar[XB_XCNT(j)]); sum += c; cnt += (c > 0u) ? 1u : 0u; mine = (j == x) ? c : mine; }
        if (sum == G) break;
        __builtin_amdgcn_s_sleep(1);
        if ((++sp & 255u) == 0u) { if (xb_ld(&bar[XB_TMO])) break; if (sp > XB_SPIN_CAP) { atomicAdd(&bar[XB_TMO], 1u); break; } }
    }
    nloc = mine > 0u ? mine : 1u; nx = cnt > 0u ? cnt : 1u;
}
__device__ __forceinline__ void xcd_barrier(unsigned* bar, volatile LAS unsigned* st, const bool leader) {
    asm volatile("s_waitcnt vmcnt(0)" ::: "memory");
    __syncthreads();
    if (leader) {
        __builtin_amdgcn_s_waitcnt(0);
        const unsigned x = xb_xcc_id();
        unsigned nloc = st[0], nx = st[1];
        if (nloc == 0u) { xcd_barrier_complete(bar, x, nloc, nx); st[0] = nloc; st[1] = nx; }
        const unsigned old = xb_add(&bar[XB_XSUB(x)], 1u);
        const unsigned gen = old / nloc;
        if (old + 1u == (gen + 1u) * nloc) {
            __builtin_amdgcn_fence(__ATOMIC_RELEASE, "agent");
            asm volatile("s_waitcnt vmcnt(0)" ::: "memory");
            const unsigned og = xb_add(&bar[XB_TOP], 1u);
            const unsigned tg = og / nx;
            if (og + 1u == (tg + 1u) * nx) xb_add(&bar[XB_TOPGEN], 1u);
            else XB_SPIN(xb_ld(&bar[XB_TOPGEN]) == tg, bar);
            __builtin_amdgcn_fence(__ATOMIC_ACQUIRE, "agent");
            xb_add(&bar[XB_XGEN(x)], 1u);
            asm volatile("s_waitcnt vmcnt(0)" ::: "memory");
        } else {
            XB_SPIN(xb_ld(&bar[XB_XGEN(x)]) == gen, bar);
            __builtin_amdgcn_fence(__ATOMIC_ACQUIRE, "agent");
            asm volatile("s_waitcnt vmcnt(0)" ::: "memory");
        }
    }
    __syncthreads();
}

struct Args { const float* in[18]; float* out; unsigned char* ws; int ph_lo, ph_hi; };
enum { IN_X = 0, IN_P, IN_GMIX, IN_WIN, IN_GQ, IN_GK, IN_CONVW, IN_WAO, IN_WCO, IN_WOUT, IN_GFFN, IN_WPQ, IN_KEYS, IN_U, IN_V, IN_GPLE, IN_WPLE, IN_WPG };

#define CAS __attribute__((address_space(4)))
typedef const float* cfptr_t; typedef float* fptr_t; typedef unsigned char* ucptr_t;
#define KARG_PTR(i) (*(const CAS cfptr_t*)(ka + 8 * (i)))
#define PH_LOCALS \
    const CAS unsigned char* ka = (const CAS unsigned char*)__builtin_amdgcn_kernarg_segment_ptr(); asm volatile("" : "+s"(ka)); \
    const int wave = wave0; \
    int lane = (int)__builtin_amdgcn_mbcnt_hi(~0u, __builtin_amdgcn_mbcnt_lo(~0u, 0u)); asm volatile("" : "+v"(lane)); \
    const int tid = wave * 64 + lane; \
    int G = gridDim.x, bx = blockIdx.x; asm volatile("" : "+s"(G), "+s"(bx)); \
    const int vcu = (G % 8 == 0) ? (bx % 8) * (G / 8) + bx / 8 : bx; \
    const int gw = vcu * NW + wave, NGW = G * NW; const int gt = vcu * (NW * 64) + tid, NGT = G * NW * 64; \
    unsigned char* ws = *(const CAS ucptr_t*)(ka + 152); float* out = *(const CAS fptr_t*)(ka + 144); \
    LAS unsigned char* L = (LAS unsigned char*)lds; \
    (void)lane; (void)wave; (void)vcu; (void)gw; (void)NGW; (void)gt; (void)NGT; (void)ws; (void)out; (void)L;

constexpr int LDS_BARST = 160768;

__global__ void __launch_bounds__(NW * 64, 2) mega_fwd(Args args) {
    extern __shared__ __attribute__((aligned(16))) unsigned char lds[];
    const int wave0 = __builtin_amdgcn_readfirstlane((int)threadIdx.x >> 6);
    const int lo = args.ph_lo, hi = args.ph_hi;
    {
        if (threadIdx.x == 0) { volatile LAS unsigned* st = (volatile LAS unsigned*)((LAS unsigned char*)lds + LDS_BARST); st[0] = 0u; st[1] = 0u;
            unsigned* bar = (unsigned*)(args.ws + WS_CTL); (void)xb_add(&bar[XB_XCNT(xb_xcc_id())], 1u); }
        __syncthreads();
    }
#ifdef ONLY_PHASE
#define IN(k) ((k) == ONLY_PHASE && lo <= (k) && (k) < hi)
#else
#define IN(k) (lo <= (k) && (k) < hi)
#endif
#define SEAM(k) do { if (IN(k) && IN((k) + 1)) { \
        const CAS unsigned char* ka_ = (const CAS unsigned char*)__builtin_amdgcn_kernarg_segment_ptr(); asm volatile("" : "+s"(ka_)); \
        const int lane_ = (int)__builtin_amdgcn_mbcnt_hi(~0u, __builtin_amdgcn_mbcnt_lo(~0u, 0u)); \
        xcd_barrier((unsigned*)(*(const CAS ucptr_t*)(ka_ + 152) + WS_CTL), (volatile LAS unsigned*)((LAS unsigned char*)lds + LDS_BARST), wave0 == 0 && lane_ == 0); } } while (0)
#define WSP(T_, off) ((T_*)(ws + (off)))

    if (IN(0)) {
        PH_LOCALS
        const float* x = KARG_PTR(IN_X);
        float* XS1 = WSP(float, WS_XS1); bf16_t* KEYBD = WSP(bf16_t, WS_KEYBD); bf16_t* WPLET = WSP(bf16_t, WS_WPLET); bf16_t* PB = WSP(bf16_t, WS_PB);
        unsigned char* WGQ = WSP(unsigned char, WS_WGQ); unsigned char* WINQ = WSP(unsigned char, WS_WINQ); unsigned* CMAX = WSP(unsigned, WS_CMAX);
        bf16_t* W3AT = WSP(bf16_t, WS_W3AT); bf16_t* WOUTT = WSP(bf16_t, WS_WOUTT); bf16_t* WQP = WSP(bf16_t, WS_WQP);
        unsigned char* UB = WSP(unsigned char, WS_UB); unsigned char* VB = WSP(unsigned char, WS_VB); unsigned char* XQ = WSP(unsigned char, WS_XB);
        LAS float* scr = (LAS float*)(L + wave * 16384);
        constexpr int I_IN = 32 * 272, I_G = 32 * 64, I_AO = 16 * 64, I_CO = 16 * 64, I_OUT = 32 * 64, I_PLE = 4 * 64;
        for (int it = gw; it < I_IN + I_G; it += NGW) {
            if (it < I_IN) { const int kb = it / 272, nb = it % 272; colmax_item(KARG_PTR(IN_WIN), W_IN, kb * 64, win_src_col(nb * 32), KARG_PTR(IN_GMIX), CMAX, nb * 32, lane); }
            else { const int r = it - I_IN, kb = r / 64, nb = r % 64; colmax_item(KARG_PTR(IN_WPG), DM, kb * 64, nb * 32, KARG_PTR(IN_GPLE), CMAX + W_IN, nb * 32, lane); }
        }
        for (int it = gw; it < I_AO + I_CO + I_OUT + I_PLE; it += NGW) {
            int r = it;
            if (r < I_AO) { const int kb = r / 64, nb = r % 64; transpose_item(KARG_PTR(IN_WAO), DM, kb * 64, nb * 32, W3AT, DM, nb * 32, kb * 64, nullptr, scr, lane); continue; } r -= I_AO;
            if (r < I_CO) { const int kb = r / 64, nb = r % 64; transpose_item(KARG_PTR(IN_WCO), DM, kb * 64, nb * 32, W3AT, DM, nb * 32, 1024 + kb * 64, nullptr, scr, lane); continue; } r -= I_CO;
            if (r < I_OUT) { const int kb = r / 64, nb = r % 64; transpose_item(KARG_PTR(IN_WOUT), DM, kb * 64, nb * 32, WOUTT, DM, nb * 32, kb * 64, nullptr, scr, lane); continue; } r -= I_OUT;
            { const int kb = r / 64, nb = r % 64; transpose_item(KARG_PTR(IN_WPLE), DM, kb * 64, nb * 32, WPLET, 256, nb * 32, kb * 64, nullptr, scr, lane); }
        }
        { const float* src = KARG_PTR(IN_WPQ); const float* gf = KARG_PTR(IN_GFFN);
          for (int i = gt; i < DM * DM / 8; i += NGT) { const float g = gf[i >> 8]; const f32x4 a = *(const f32x4*)(src + (size_t)i * 8), b = *(const f32x4*)(src + (size_t)i * 8 + 4);
              u32x4 w; w.x = pk2(a[0] * g, a[1] * g); w.y = pk2(a[2] * g, a[3] * g); w.z = pk2(b[0] * g, b[1] * g); w.w = pk2(b[2] * g, b[3] * g); *(u32x4*)(WQP + (size_t)i * 8) = w; } }
        { const float* src = KARG_PTR(IN_P);
          for (int i = gt; i < T * 256 / 8; i += NGT) { const f32x4 a = *(const f32x4*)(src + (size_t)i * 8), b = *(const f32x4*)(src + (size_t)i * 8 + 4);
              u32x4 w; w.x = pk2(a[0], a[1]); w.y = pk2(a[2], a[3]); w.z = pk2(b[0], b[1]); w.w = pk2(b[2], b[3]); *(u32x4*)(PB + (size_t)i * 8) = w; } }
        { const float* src = KARG_PTR(IN_KEYS);
          for (int i = gt; i < 2048 * 256 / 8; i += NGT) { const int row = i >> 5, c8 = (i & 31) * 8, hp = row >> 7; u32x4 w = {0u, 0u, 0u, 0u};
              if ((c8 >> 7) == (hp & 1)) { const float* s = src + (size_t)row * 128 + (c8 & 127); const f32x4 a = *(const f32x4*)s, b = *(const f32x4*)(s + 4);
                  w.x = pk2(a[0], a[1]); w.y = pk2(a[2], a[3]); w.z = pk2(b[0], b[1]); w.w = pk2(b[2], b[3]); }
              *(u32x4*)(KEYBD + (size_t)i * 8) = w; } }
        { const float* su = KARG_PTR(IN_U); const float* gf = KARG_PTR(IN_GFFN); float* SU = WSP(float, WS_SU); f32x4 g4[8];
#pragma unroll
          for (int j = 0; j < 8; ++j) g4[j] = ((const f32x4*)gf)[8 * lane + j];
          for (int e = gw; e < 16384; e += NGW) { const f32x4* ur = (const f32x4*)(su + (size_t)e * DM) + 8 * lane; f32x4 v[8]; float am = 0.f, ss = 0.f;
#pragma unroll
              for (int j = 0; j < 8; ++j) { v[j] = ur[j] * g4[j]; am = fmaxf(fmaxf(am, fmaxf(fabsf(v[j][0]), fabsf(v[j][1]))), fmaxf(fabsf(v[j][2]), fabsf(v[j][3])));
                  ss += (v[j][0] * v[j][0] + v[j][1] * v[j][1]) + (v[j][2] * v[j][2] + v[j][3] * v[j][3]); }
#pragma unroll
              for (int o = 1; o < 64; o <<= 1) { am = fmaxf(am, __shfl_xor(am, o)); ss += __shfl_xor(ss, o); }
              const float step = fminf(am * 0.125f, 0.3352f * sqrtf(ss * (1.0f / DM)));
              if (lane == 0) SU[e] = step;
              const float inv = step > 0.f ? 1.0f / step : 0.f; u32x4 w;
#pragma unroll
              for (int q = 0; q < 4; ++q) { unsigned r = 0u;
#pragma unroll
                  for (int i = 0; i < 8; ++i) { const float f = floorf(v[2 * q + (i >> 2)][i & 3] * inv); const int n = (int)fminf(fmaxf(f, -8.0f), 7.0f); r |= ((unsigned)n & 15u) << (4 * ((i < 4) ? 2 * i : 2 * (i - 4) + 1)); }
                  w[q] = r; }
              *(u32x4*)(UB + (size_t)(lane >> 3) * (16384u * 128u) + (size_t)e * 128u + (lane & 7) * 16) = w; } }
        { const float* sv = KARG_PTR(IN_V); float* SV = WSP(float, WS_SV);
          for (int e = gw; e < 16384; e += NGW) { const f32x4* vr = (const f32x4*)(sv + (size_t)e * DM) + 8 * lane; f32x4 v[8]; float am = 0.f, ss = 0.f;
#pragma unroll
              for (int j = 0; j < 8; ++j) { v[j] = vr[j]; am = fmaxf(fmaxf(am, fmaxf(fabsf(v[j][0]), fabsf(v[j][1]))), fmaxf(fabsf(v[j][2]), fabsf(v[j][3])));
                  ss += (v[j][0] * v[j][0] + v[j][1] * v[j][1]) + (v[j][2] * v[j][2] + v[j][3] * v[j][3]); }
#pragma unroll
              for (int o = 1; o < 64; o <<= 1) { am = fmaxf(am, __shfl_xor(am, o)); ss += __shfl_xor(ss, o); }
              const float step = fminf(am * 0.125f, 0.3352f * sqrtf(ss * (1.0f / DM)));
              if (lane == 0) SV[e] = step;
              const float inv = step > 0.f ? 1.0f / step : 0.f; u32x4 w;
#pragma unroll
              for (int q = 0; q < 4; ++q) { unsigned r = 0u;
#pragma unroll
                  for (int i = 0; i < 8; ++i) { const float f = floorf(v[i][q] * inv); const int n = (int)fminf(fmaxf(f, -8.0f), 7.0f); r |= ((unsigned)n & 15u) << (4 * i); }
                  w[q] = r; }
              { const int k_ = lane & 7, src0 = (lane & ~7) + 4 * (k_ & 1); u32x4 o;
#pragma unroll
                for (int j = 0; j < 4; ++j) { const unsigned a0 = __shfl(w[0], src0 + j), a1 = __shfl(w[1], src0 + j), a2 = __shfl(w[2], src0 + j), a3 = __shfl(w[3], src0 + j);
                    o[j] = (k_ < 4) ? ((k_ < 2) ? a0 : a1) : ((k_ < 6) ? a2 : a3); }
                *(u32x4*)(VB + (size_t)(lane >> 3) * (16384u * 128u) + (size_t)e * 128u + k_ * 16) = o; } } }
        for (int m = gw; m < T; m += NGW) { const f32x4* xr = (const f32x4*)(x + (size_t)m * DM) + lane; f32x4 v[8]; float s = 0.f, am = 0.f;
#pragma unroll
            for (int j = 0; j < 8; ++j) { v[j] = xr[64 * j]; s += (v[j][0] * v[j][0] + v[j][1] * v[j][1]) + (v[j][2] * v[j][2] + v[j][3] * v[j][3]);
                am = fmaxf(fmaxf(am, fmaxf(fabsf(v[j][0]), fabsf(v[j][1]))), fmaxf(fabsf(v[j][2]), fabsf(v[j][3]))); }
            s = wave_sum(s);
#pragma unroll
            for (int o = 1; o < 64; o <<= 1) am = fmaxf(am, __shfl_xor(am, o));
            if (lane == 0) XS1[m] = (1.0f / sqrtf(s * (1.0f / DM) + EPS)) * am * (1.0f / 127.0f);
            const float sc = am > 0.f ? 127.0f / am : 0.f;
            unsigned* o = (unsigned*)(XQ + (size_t)m * DM) + lane;
#pragma unroll
            for (int j = 0; j < 8; ++j) o[64 * j] = q8x4(v[j][0] * sc, v[j][1] * sc, v[j][2] * sc, v[j][3] * sc); }
        xcd_barrier((unsigned*)(ws + WS_CTL), (volatile LAS unsigned*)(L + LDS_BARST), wave == 0 && lane == 0);
        for (int it = gw; it < I_IN + I_G; it += NGW) {
            if (it < I_IN) { const int kb = it / 272, nb = it % 272; quant_transpose_item(KARG_PTR(IN_WIN), W_IN, kb * 64, win_src_col(nb * 32), WINQ, DM, nb * 32, kb * 64, KARG_PTR(IN_GMIX), CMAX, scr, lane); }
            else { const int r = it - I_IN, kb = r / 64, nb = r % 64; quant_transpose_item(KARG_PTR(IN_WPG), DM, kb * 64, nb * 32, WGQ, DM, nb * 32, kb * 64, KARG_PTR(IN_GPLE), CMAX + W_IN, scr, lane); }
        }
    }
    SEAM(0);

    if (IN(1)) {
        PH_LOCALS
        unsigned char* XQ = WSP(unsigned char, WS_XB); unsigned char* WINQ = WSP(unsigned char, WS_WINQ); bf16_t* KEYBD = WSP(bf16_t, WS_KEYBD); bf16_t* WQP = WSP(bf16_t, WS_WQP); bf16_t* WQKT = WSP(bf16_t, WS_WQKT);
        bf16_t* QB = WSP(bf16_t, WS_Q); bf16_t* KVB = WSP(bf16_t, WS_KV); bf16_t* PROD = WSP(bf16_t, WS_PROD); bf16_t* CBB = WSP(bf16_t, WS_CB); unsigned char* SGA = WSP(unsigned char, WS_SGA); unsigned char* SGC = WSP(unsigned char, WS_SGC);
        float* XS1 = WSP(float, WS_XS1); const float* CMAXF = WSP(float, WS_CMAX);
        { pg8::Gemm g{XQ, WINQ, DM, DM, DM, 0}; pg8::StaticOrder S; S.init(T, W_IN, G, bx);
          pg8::Epi1 E{QB, KVB, PROD, CBB, SGA, SGC, XS1, CMAXF};
          pg8::gemm_phase<pg8::Epi1, pg8::StaticOrder, true>(L, g, S, E, tid, wave); }
        { pg8::Gemm g{KEYBD, WQP, 512, 512, 2 * DM, 512}; pg8::StaticOrder S; S.init(2048, 2048, G, (bx >= G - 64) ? bx - (G - 64) : (1 << 24));
          pg8::EpiBf16 E{WQKT, DM};
          pg8::gemm_phase<pg8::EpiBf16, pg8::StaticOrder>(L, g, S, E, tid, wave); }
    }
    SEAM(1);

    if (IN(2)) {
        PH_LOCALS
        bf16_t* QB = WSP(bf16_t, WS_Q); bf16_t* KVB = WSP(bf16_t, WS_KV); bf16_t* PROD = WSP(bf16_t, WS_PROD); bf16_t* CBB = WSP(bf16_t, WS_CB); bf16_t* AC = WSP(bf16_t, WS_XB);
        const float* gq = KARG_PTR(IN_GQ); const float* gk = KARG_PTR(IN_GK);
        { LAS f32x2* LT = (LAS f32x2*)L;
#pragma unroll
          for (int k = 0; k < 4; ++k) { const int idx = tid + 512 * k, pos = idx >> 5, f = idx & 31; const float inv = powf(10000.0f, -(float)(2 * f) / 64.0f);
              float sn, cs; sincosf((float)pos * inv, &sn, &cs); LT[idx] = (f32x2){cs, sn}; }
          __syncthreads(); }
        { const LAS f32x2* LT = (const LAS f32x2*)L; const int l7 = lane & 7, fb = 16 * (lane & 1); const bool axc = (l7 >> 2) != 0, neg = (lane & 3) < 2;
          float gqv[16], gkv[16];
#pragma unroll
          for (int e = 0; e < 16; ++e) { gqv[e] = gq[16 * l7 + e]; gkv[e] = gk[16 * l7 + e]; }
#define QK_ROW(A_, B_, GV, SQ) do { float xx[16]; \
              xx[0] = bflo(A_.x); xx[1] = bfhi(A_.x); xx[2] = bflo(A_.y); xx[3] = bfhi(A_.y); xx[4] = bflo(A_.z); xx[5] = bfhi(A_.z); xx[6] = bflo(A_.w); xx[7] = bfhi(A_.w); \
              xx[8] = bflo(B_.x); xx[9] = bfhi(B_.x); xx[10] = bflo(B_.y); xx[11] = bfhi(B_.y); xx[12] = bflo(B_.z); xx[13] = bfhi(B_.z); xx[14] = bflo(B_.w); xx[15] = bfhi(B_.w); \
              float ss_ = 0.f; _Pragma("unroll") for (int e = 0; e < 16; ++e) ss_ += xx[e] * xx[e]; \
              ss_ += dppf<DPP_X1>(ss_); ss_ += dppf<DPP_X2>(ss_); ss_ += dppf<DPP_HMIR>(ss_); \
              const float r_ = 1.0f / sqrtf(ss_ * (1.0f / 128.0f) + EPS); \
              const LAS f32x2* lt_ = LT + (axc ? ((SQ) & 63) : ((SQ) >> 6)) * 32 + fb; float oo[16]; \
              _Pragma("unroll") for (int e = 0; e < 16; ++e) { const float y_ = xx[e] * r_ * GV[e]; const float p_ = dppf<DPP_X2>(y_); const f32x2 cs_ = lt_[e]; oo[e] = y_ * cs_.x + (neg ? -p_ : p_) * cs_.y; } \
              A_.x = pk2(oo[0], oo[1]); A_.y = pk2(oo[2], oo[3]); A_.z = pk2(oo[4], oo[5]); A_.w = pk2(oo[6], oo[7]); B_.x = pk2(oo[8], oo[9]); B_.y = pk2(oo[10], oo[11]); B_.z = pk2(oo[12], oo[13]); B_.w = pk2(oo[14], oo[15]); } while (0)
          { int t = gw; u32x4 a = {0u, 0u, 0u, 0u}, c = a; if (t < T) { const u32x4* p = (const u32x4*)(QB + (size_t)t * 1024 + 16 * lane); a = p[0]; c = p[1]; }
            for (; t < T; t += NGW) { const int tn = t + NGW; u32x4 na = a, nc = c; if (tn < T) { const u32x4* p = (const u32x4*)(QB + (size_t)tn * 1024 + 16 * lane); na = p[0]; nc = p[1]; }
                const int sq = t & (SEQ - 1); QK_ROW(a, c, gqv, sq);
                u32x4* q = (u32x4*)(QB + (size_t)t * 1024 + 16 * lane); q[0] = a; q[1] = c; a = na; c = nc; } }
          { const int sub = lane >> 4, l15 = lane & 15; int t4 = gw; u32x4 a = {0u, 0u, 0u, 0u}, c = a;
            if (t4 < T / 4) { const u32x4* p = (const u32x4*)(KVB + (size_t)(t4 * 4 + sub) * 512 + 16 * l15); a = p[0]; c = p[1]; }
            for (; t4 < T / 4; t4 += NGW) { const int tn = t4 + NGW; u32x4 na = a, nc = c; if (tn < T / 4) { const u32x4* p = (const u32x4*)(KVB + (size_t)(tn * 4 + sub) * 512 + 16 * l15); na = p[0]; nc = p[1]; }
                const int sq = (t4 * 4 + sub) & (SEQ - 1); QK_ROW(a, c, gkv, sq);
                u32x4* q = (u32x4*)(KVB + (size_t)(t4 * 4 + sub) * 512 + 16 * l15); q[0] = a; q[1] = c; a = na; c = nc; } }
#undef QK_ROW
        }
        { const float* cw = KARG_PTR(IN_CONVW); const int c8 = (gt & 127) * 8;
          const f32x4 w0a = *(const f32x4*)(cw + c8), w0b = *(const f32x4*)(cw + c8 + 4), w1a = *(const f32x4*)(cw + 1024 + c8), w1b = *(const f32x4*)(cw + 1024 + c8 + 4), w2a = *(const f32x4*)(cw + 2048 + c8), w2b = *(const f32x4*)(cw + 2048 + c8 + 4);
          const int step = ((NGT & 127) == 0) ? NGT : 128 * NGT;
          const u32x4 z = {0u, 0u, 0u, 0u};
#define CV_LOAD(I, PM, PC, PP, CB) do { const int t_ = (I) >> 7, sq_ = t_ & (SEQ - 1); const size_t off_ = (size_t)t_ * 1024 + c8; \
              PM = (sq_ > 0) ? *(const u32x4*)(PROD + off_ - 1024) : z; PC = *(const u32x4*)(PROD + off_); PP = (sq_ < SEQ - 1) ? *(const u32x4*)(PROD + off_ + 1024) : z; CB = *(const u32x4*)(CBB + off_); } while (0)
          u32x4 pm = z, pc = z, pp = z, cb = z; int i = gt;
          if (i < T * 128) CV_LOAD(i, pm, pc, pp, cb);
          for (; i < T * 128; i += step) { const int t = i >> 7;
            u32x4 npm = z, npc = z, npp = z, ncb = z; if (i + step < T * 128) CV_LOAD(i + step, npm, npc, npp, ncb);
            float o[8];
            o[0] = bflo(cb.x) * (w0a[0] * bflo(pm.x) + w1a[0] * bflo(pc.x) + w2a[0] * bflo(pp.x)); o[1] = bfhi(cb.x) * (w0a[1] * bfhi(pm.x) + w1a[1] * bfhi(pc.x) + w2a[1] * bfhi(pp.x));
            o[2] = bflo(cb.y) * (w0a[2] * bflo(pm.y) + w1a[2] * bflo(pc.y) + w2a[2] * bflo(pp.y)); o[3] = bfhi(cb.y) * (w0a[3] * bfhi(pm.y) + w1a[3] * bfhi(pc.y) + w2a[3] * bfhi(pp.y));
            o[4] = bflo(cb.z) * (w0b[0] * bflo(pm.z) + w1b[0] * bflo(pc.z) + w2b[0] * bflo(pp.z)); o[5] = bfhi(cb.z) * (w0b[1] * bfhi(pm.z) + w1b[1] * bfhi(pc.z) + w2b[1] * bfhi(pp.z));
            o[6] = bflo(cb.w) * (w0b[2] * bflo(pm.w) + w1b[2] * bflo(pc.w) + w2b[2] * bflo(pp.w)); o[7] = bfhi(cb.w) * (w0b[3] * bfhi(pm.w) + w1b[3] * bfhi(pc.w) + w2b[3] * bfhi(pp.w));
            u32x4 w; w.x = pk2(o[0], o[1]); w.y = pk2(o[2], o[3]); w.z = pk2(o[4], o[5]); w.w = pk2(o[6], o[7]);
            *(u32x4*)(AC + (size_t)t * DM + 1024 + c8) = w;
            pm = npm; pc = npc; pp = npp; cb = ncb; } }
#undef CV_LOAD
    }
    SEAM(2);

    if (IN(3)) {
        PH_LOCALS
        bf16_t* QB = WSP(bf16_t, WS_Q); bf16_t* KVB = WSP(bf16_t, WS_KV); bf16_t* AC = WSP(bf16_t, WS_XB);
        for (int u = vcu; u < 4 * 8 * 16; u += G) { const int qb = u & 15, bh = u >> 4, h = bh & 7, b = bh >> 3, kvh = h >> 2;
            const size_t r0 = (size_t)b * SEQ;
            attn::attn_dense_body(QB + (r0 + qb * 256) * 1024 + h * 128, KVB + r0 * 512 + kvh * 128, KVB + r0 * 512 + 256 + kvh * 128, AC + (r0 + qb * 256) * DM + h * 128, SEQ, (char*)lds, tid, wave);
            __syncthreads(); }
    }
    SEAM(3);

    if (IN(4)) {
        PH_LOCALS
        bf16_t* AC = WSP(bf16_t, WS_XB); bf16_t* W3AT = WSP(bf16_t, WS_W3AT); unsigned char* SGA = WSP(unsigned char, WS_SGA); unsigned char* SGC = WSP(unsigned char, WS_SGC); bf16_t* MERGED = WSP(bf16_t, WS_MERGED);
        pg8::Gemm g{AC, W3AT, 2 * DM, 2 * DM, 2 * DM, 0}; pg8::StaticOrder S; S.init(T, DM, G, bx);
        pg8::Epi3a E{SGA, SGC, MERGED};
        pg8::gemm_phase<pg8::Epi3a, pg8::StaticOrder>(L, g, S, E, tid, wave);
    }
    SEAM(4);

    if (IN(5)) {
        PH_LOCALS
        const float* x = KARG_PTR(IN_X);
        bf16_t* MERGED = WSP(bf16_t, WS_MERGED); bf16_t* WOUTT = WSP(bf16_t, WS_WOUTT); bf16_t* X1B = WSP(bf16_t, WS_SGA); float* SSQ = WSP(float, WS_SSQ);
        pg8::Gemm g{MERGED, WOUTT, 2 * DM, 2 * DM, 2 * DM, 0}; pg8::StaticOrder S; S.init(T, DM, G, bx);
        pg8::Epi3b E{x, X1B, SSQ};
        pg8::gemm_phase<pg8::Epi3b, pg8::StaticOrder>(L, g, S, E, tid, wave);
    }
    SEAM(5);

    if (IN(6)) {
        PH_LOCALS
        bf16_t* X1B = WSP(bf16_t, WS_SGA); bf16_t* WQKT = WSP(bf16_t, WS_WQKT); unsigned short* SCORES = WSP(unsigned short, WS_SCORES); bf16_t* PB = WSP(bf16_t, WS_PB); bf16_t* WPLET = WSP(bf16_t, WS_WPLET); bf16_t* PE = WSP(bf16_t, WS_XB);
        { pg8::Gemm g{X1B, WQKT, 2 * DM, 2 * DM, 2 * DM, 0}; pg8::StaticOrder S; S.init(T, DM, G, bx);
          pg8::EpiF16 E{SCORES, DM};
          pg8::gemm_phase<pg8::EpiF16, pg8::StaticOrder>(L, g, S, E, tid, wave); }
    }
    SEAM(6);

    if (IN(7)) {
        PH_LOCALS
        float* SSQ = WSP(float, WS_SSQ); unsigned short* SCORES = WSP(unsigned short, WS_SCORES); bf16_t* X1B = WSP(bf16_t, WS_SGA); bf16_t* UB = WSP(bf16_t, WS_UB); bf16_t* VB = WSP(bf16_t, WS_VB);
        bf16_t* X2B = WSP(bf16_t, WS_X2B); float* XS2 = WSP(float, WS_XS2); unsigned char* X2Q = WSP(unsigned char, WS_X2Q); const float* SV = WSP(float, WS_SV); const float* SU = WSP(float, WS_SU); unsigned char* XD = WSP(unsigned char, WS_XD);
        LAS unsigned char* Lw = L + wave * 20096;
        LAS unsigned* LK = (LAS unsigned*)(Lw);
        LAS float* SELV = (LAS float*)(Lw + 1024);
        LAS unsigned* SELI = (LAS unsigned*)(Lw + 1536);
        LAS unsigned* EIT = (LAS unsigned*)(Lw + 2048);
        LAS float* HIT = (LAS float*)(Lw + 6144);
        LAS float* RST = (LAS float*)(Lw + 19456);
        LAS float* HSQ = (LAS float*)(Lw + 19488);
        LAS float* AM1 = (LAS float*)(Lw + 19520);
        LAS float* STG = (LAS float*)(Lw + 10240);
        LAS float* ACT = (LAS float*)(Lw + 10240);
        constexpr int TPW = 8;
        for (int tb = gw * TPW; tb < T; tb += NGW * TPW) {
#pragma unroll 1
            for (int ti = 0; ti < TPW; ++ti) {
                const int t = tb + ti;
                int ln_ = lane; asm volatile("" : "+v"(ln_));
                float rstd1;
                unsigned ka[16], kb[16];
                {
                  const u32x4* sp = (const u32x4*)((const char*)SCORES + (unsigned)t * (DM * 2u)) + ln_; u32x4 fr[4];
#pragma unroll
                  for (int j = 0; j < 4; ++j) fr[j] = sp[64 * j];
                  {
                    const u32x4* xp = (const u32x4*)((const char*)X1B + ((unsigned)t * DM + 32u * ln_) * 2u); u32x4 xr[4];
#pragma unroll
                    for (int q = 0; q < 4; ++q) xr[q] = xp[q];
                    float am = 0.f, ssl = 0.f;
#pragma unroll
                    for (int q = 0; q < 4; ++q)
#pragma unroll
                        for (int c = 0; c < 4; ++c) { const float e0 = bflo(xr[q][c]), e1 = bfhi(xr[q][c]); am = fmaxf(am, fmaxf(fabsf(e0), fabsf(e1))); ssl = fmaf(e0, e0, fmaf(e1, e1, ssl)); }
                    rstd1 = 1.0f / sqrtf(wave_sum(ssl) * (1.0f / DM) + EPS);
                    am = fmaxf(am, dppf<DPP_X1>(am)); am = fmaxf(am, dppf<DPP_X2>(am)); am = fmaxf(am, dppf<DPP_HMIR>(am)); am = fmaxf(am, dppf<DPP_MIR>(am));
                    am = fmaxf(am, __shfl_xor(am, 16)); am = fmaxf(am, __shfl_xor(am, 32));
                    const float qs = am > 0.f ? 119.0f / am : 0.f; u32x4 dh, dl; unsigned sqb = 0u;
#pragma unroll
                    for (int q = 0; q < 4; ++q) { unsigned ya = 0u, yb = 0u;
#pragma unroll
                        for (int i = 0; i < 8; ++i) { const unsigned wv = xr[q][i >> 1]; const int y = (int)fmaf((i & 1) ? bfhi(wv) : bflo(wv), qs, 136.5f);
                            if (i < 4) ya = __builtin_amdgcn_alignbit((unsigned)y, ya, 8); else yb = __builtin_amdgcn_alignbit((unsigned)y, yb, 8); }
                        sqb = __builtin_amdgcn_sad_u8(ya, 0u, sqb); sqb = __builtin_amdgcn_sad_u8(yb, 0u, sqb);
                        dl[q] = ((ya & 0x0F0F0F0Fu) | ((yb & 0x0F0F0F0Fu) << 4)) ^ 0x88888888u;
                        dh[q] = (((ya >> 4) & 0x0F0F0F0Fu) | (yb & 0xF0F0F0F0u)) ^ 0x88888888u; }
                    const int sq = (int)sqb - 136 * 32;
                    *(u32x4*)(XD + ((unsigned)t * 2048u + 32u * ln_)) = dh; *(u32x4*)(XD + ((unsigned)t * 2048u + 32u * ln_ + 16u)) = dl;
                    float sqf = (float)sq; sqf = wave_sum(sqf);
                    if (ln_ == 0) { RST[ti] = rstd1 * (am * (1.0f / 119.0f)); HSQ[ti] = 0.5f * sqf; AM1[ti] = am; } }
#pragma unroll
                  for (int j = 0; j < 4; ++j) *(LAS u32x4*)((LAS unsigned char*)STG + (((ln_ >> 2) + 16 * j) * 80 + 16 * (ln_ & 3))) = fr[j];
                  LDS_WAIT();
                  const LAS u32x4* lp = (const LAS u32x4*)((LAS unsigned char*)STG + ln_ * 80); const unsigned nb = (unsigned)(lane & 3) * 32u;
#pragma unroll
                  for (int j = 0; j < 2; ++j) { const u32x4 v = lp[j];
#pragma unroll
                      for (int c = 0; c < 4; ++c) { const unsigned w_ = v[c], o_ = h2ord2(w_);
                          ka[8 * j + 2 * c] = (o_ << 16) | (nb + 8 * j + 2 * c); ka[8 * j + 2 * c + 1] = (o_ & 0xFFFF0000u) | (nb + 8 * j + 2 * c + 1); } }
#pragma unroll
                  for (int j = 0; j < 2; ++j) { const u32x4 v = lp[2 + j];
#pragma unroll
                      for (int c = 0; c < 4; ++c) { const unsigned w_ = v[c], o_ = h2ord2(w_);
                          kb[8 * j + 2 * c] = (o_ << 16) | (nb + 16 + 8 * j + 2 * c); kb[8 * j + 2 * c + 1] = (o_ & 0xFFFF0000u) | (nb + 16 + 8 * j + 2 * c + 1); } }
                  LDS_WAIT(); }
                sort16_desc(ka); sort16_desc(kb);
                unsigned kc[16];
#pragma unroll
                for (int i = 0; i < 16; ++i) kc[i] = umax_(ka[i], kb[15 - i]);
                bitonic_merge_desc<16>(kc);
#pragma unroll
                for (int i = 0; i < 16; ++i) ka[i] = umax_(kc[i], dppu<DPP_X1>(kc[15 - i]));
                bitonic_merge_desc<16>(ka);
#pragma unroll
                for (int i = 0; i < 16; ++i) kc[i] = umax_(ka[i], dppu<DPP_X2>(ka[15 - i]));
                bitonic_merge_desc<16>(kc);
                if ((lane & 3) == 0) {
#pragma unroll
                    for (int i = 0; i < 4; ++i) { u32x4 w = {kc[4 * i], kc[4 * i + 1], kc[4 * i + 2], kc[4 * i + 3]}; *(LAS u32x4*)(LK + (lane >> 2) * 16 + 4 * i) = w; } }
                LDS_WAIT();
                { const int h = lane >> 3, j = lane & 7;
                  const LAS unsigned* L0 = LK + (2 * h) * 16; const LAS unsigned* L1 = LK + (2 * h + 1) * 16;
                  const unsigned k0a = L0[j], k0e = L0[j + 8], k10 = L1[0];
                  const float v0a = okey2f(k0a), v0e = okey2f(k0e), v10 = okey2f(k10);
                  const unsigned i0a = k0a & 0x7Fu, i0e = k0e & 0x7Fu, i10 = k10 & 0x7Fu;
                  float fv = v0a + v10; unsigned fi1 = i10; int ptr = 0; bool fvalid = true;
                  const float ev = v0e + v10; bool evalid = true;
                  for (int r = 0; r < 16; ++r) {
                      const unsigned kf = fvalid ? ((f2ord(fv) & ~0xFu) | (unsigned)(j << 1)) : 0u;
                      const unsigned ke = evalid ? ((f2ord(ev) & ~0xFu) | (unsigned)(j << 1) | 1u) : 0u;
                      unsigned gm = umax_(kf, ke);
                      gm = umax_(gm, dppu<DPP_X1>(gm)); gm = umax_(gm, dppu<DPP_X2>(gm)); gm = umax_(gm, dppu<DPP_HMIR>(gm));
                      if (fvalid && gm == kf) {
                          SELV[h * 16 + r] = fv; SELI[h * 16 + r] = i0a * 128u + fi1;
                          ++ptr;
                          if (ptr < 16) { const unsigned kk = L1[ptr]; fv = v0a + okey2f(kk); fi1 = kk & 0x7Fu; } else fvalid = false;
                      } else if (evalid && gm == ke) {
                          SELV[h * 16 + r] = ev; SELI[h * 16 + r] = i0e * 128u + i10; evalid = false;
                      }
                  } }
                LDS_WAIT();
                { const float m0 = rstd1 * SELV[lane & ~15], m1 = rstd1 * SELV[64 + (lane & ~15)];
                  const float p0 = __expf(rstd1 * SELV[lane] - m0), p1 = __expf(rstd1 * SELV[64 + lane] - m1);
                  float s0 = p0, s1 = p1;
                  s0 += dppf<DPP_X1>(s0); s0 += dppf<DPP_X2>(s0); s0 += dppf<DPP_HMIR>(s0); s0 += dppf<DPP_MIR>(s0);
                  s1 += dppf<DPP_X1>(s1); s1 += dppf<DPP_X2>(s1); s1 += dppf<DPP_HMIR>(s1); s1 += dppf<DPP_MIR>(s1);
                  EIT[ti * 128 + lane] = SELI[lane] * 128u; EIT[ti * 128 + 64 + lane] = SELI[64 + lane] * 128u;
                  HIT[ti * 128 + lane] = p0 / s0; HIT[ti * 128 + 64 + lane] = p1 / s1;
                  }
                LDS_WAIT();
            }
            const int lg = lane >> 3, l16 = (lane & 7) * 16;
            asm volatile("s_waitcnt vmcnt(0)" ::: "memory");
            static_assert(TPW == 8, "u sweep: two halves of 4 tokens; v sweep: 8 tokens x 8 pieces per wave");
#pragma unroll 1
            for (int half = 0; half < 2; ++half) { const int tbh = tb + 4 * half;
            int acc[4][16];
#pragma unroll
            for (int i = 0; i < 4; ++i)
#pragma unroll
                for (int k = 0; k < 16; ++k) acc[i][k] = 0;
#define U_ISSUE(W, X, xbuf, cc, ii) do { const LAS unsigned char* xp_ = XL + (xbuf) * 1024 + (ii) * 256 + 2 * l16;     \
                X[0] = *(const LAS u32x4*)(xp_); X[1] = *(const LAS u32x4*)(xp_ + 16); \
                unsigned e_[16]; \
                _Pragma("unroll") for (int k = 0; k < 16; ++k) e_[k] = eit[(ii) * 128 + 8 * k]; \
                _Pragma("unroll") for (int k = 0; k < 16; ++k) W[k] = *(const u32x4*)((const unsigned char*)UB + (e_[k] + (unsigned)(cc) * (16384u * 128u) + (unsigned)l16)); \
                __builtin_amdgcn_sched_barrier(0); } while (0)
#define U_COMPUTE(W, X, ii) do {     \
                _Pragma("unroll") for (int k = 0; k < 16; ++k) { int th = 0, d = acc[ii][k]; \
                    _Pragma("unroll") for (int q = 0; q < 4; ++q) { th = __builtin_amdgcn_sdot8((int)W[k][q], (int)X[0][q], th, false); d = __builtin_amdgcn_sdot8((int)W[k][q], (int)X[1][q], d, false); } \
                    acc[ii][k] = d + (th << 4); } \
                __builtin_amdgcn_sched_barrier(0); } while (0)
            {
                u32x4 wA[16], wB[16], xA[2], xB[2];
                const int crev = half ? 7 : 0;
                LAS unsigned char* XL = Lw + 14336;
                const unsigned xsrc_ = (unsigned)(tbh + (lane >> 4)) * 2048u + (unsigned)(lane & 15) * 16u;
                { const u32x4 x0_ = *(const u32x4*)(XD + (xsrc_ + 256u * (unsigned)crev)); *(LAS u32x4*)(XL + 16 * lane) = x0_; LDS_WAIT(); }
                { const LAS unsigned* eit = EIT + lg + half * 512; U_ISSUE(wA, xA, 0, crev, 0); }
#pragma unroll 1
                for (int c = 0; c < 8; ++c) {
                    int zo = 0; asm volatile("" : "+v"(zo));
                    const LAS unsigned* eit = EIT + lg + half * 512 + zo; const int cc_ = c ^ crev, cn = ((c < 7) ? c + 1 : 7) ^ crev; const int xb_ = c & 1;
                    const u32x4 xn_ = *(const u32x4*)(XD + (xsrc_ + 256u * (unsigned)cn));
                    U_ISSUE(wB, xB, xb_, cc_, 1); U_COMPUTE(wA, xA, 0);
                    U_ISSUE(wA, xA, xb_, cc_, 2); U_COMPUTE(wB, xB, 1);
                    U_ISSUE(wB, xB, xb_, cc_, 3); U_COMPUTE(wA, xA, 2);
                    *(LAS u32x4*)(XL + (xb_ ^ 1) * 1024 + 16 * lane) = xn_; LDS_WAIT();
                    U_ISSUE(wA, xA, xb_ ^ 1, cn, 0); U_COMPUTE(wB, xB, 3);
                }
            }
#undef U_ISSUE
#undef U_COMPUTE
            { int lane3h_ = lane; asm volatile("" : "+v"(lane3h_)); const int lg3 = lane3h_ >> 3;
#pragma unroll
              for (int i = 0; i < 4; ++i)
#pragma unroll
                  for (int k = 0; k < 16; ++k) { unsigned d = (unsigned)acc[i][k]; d += dppu<DPP_X1>(d); d += dppu<DPP_X2>(d); d += dppu<DPP_HMIR>(d); if ((lane3h_ & 7) == 0) ACT[(4 * half + i) * 128 + 8 * k + lg3] = (float)(int)d; } }
            }
            int lane3_ = lane; asm volatile("" : "+v"(lane3_));
            LDS_WAIT();
#pragma unroll 1
            for (int i = 0; i < TPW; ++i) { const float r1 = RST[i], hq = HSQ[i];
#pragma unroll
                for (int hh = 0; hh < 2; ++hh) { const int j = i * 128 + 64 * hh + lane3_; const unsigned ej = EIT[j] >> 7; const float a = r1 * SU[ej] * (ACT[j] + hq); const float svj = SV[ej];
                    HIT[j] = 0.5f * a * (1.0f + erff(a * 0.70710678118654752f)) * HIT[j] * svj; } }
            LDS_WAIT();
            { LAS unsigned short* E16 = (LAS unsigned short*)Lw; LAS unsigned* HDW = (LAS unsigned*)(Lw + 2048); LAS float* SH = (LAS float*)(Lw + 3072); LAS float* SQH = SH + 8;
              LAS unsigned char* YB = Lw + 10240; LAS unsigned char* RING = Lw + 3584;
              { unsigned ev[16];
#pragma unroll
                for (int k = 0; k < 16; ++k) ev[k] = EIT[64 * k + lane3_] >> 7;
                LDS_WAIT();
#pragma unroll
                for (int k = 0; k < 16; ++k) E16[64 * k + lane3_] = (unsigned short)ev[k];
                LDS_WAIT(); }
#pragma unroll 1
              for (int i = 0; i < TPW; ++i) {
                  const float h0 = HIT[i * 128 + lane3_], h1 = HIT[i * 128 + 64 + lane3_];
                  float hm = fmaxf(fabsf(h0), fabsf(h1));
                  hm = fmaxf(hm, dppf<DPP_X1>(hm)); hm = fmaxf(hm, dppf<DPP_X2>(hm)); hm = fmaxf(hm, dppf<DPP_HMIR>(hm)); hm = fmaxf(hm, dppf<DPP_MIR>(hm));
                  hm = fmaxf(hm, __shfl_xor(hm, 16)); hm = fmaxf(hm, __shfl_xor(hm, 32));
                  const float qs = hm > 0.f ? 119.0f / hm : 0.f;
                  const int y0 = (int)floorf(fmaf(h0, qs, 8.5f)), y1 = (int)floorf(fmaf(h1, qs, 8.5f));
                  float sqf = (float)(y0 + y1 - 16); sqf = wave_sum(sqf);
                  YB[i * 128 + lane3_] = (unsigned char)y0; YB[i * 128 + 64 + lane3_] = (unsigned char)y1;
                  if (lane3_ == 0) { SH[i] = hm * (1.0f / 119.0f); SQH[i] = 0.5f * sqf; } }
              LDS_WAIT();
#pragma unroll
              for (int r = 0; r < 2; ++r) {
                  const int pi = lane3_ + 64 * r; const u32x2 yy = *(const LAS u32x2*)(YB + 8 * pi);
                  unsigned la = yy.x & 0x0F0F0F0Fu, lb = yy.y & 0x0F0F0F0Fu, ha = (yy.x >> 4) & 0x0F0F0F0Fu, hb = (yy.y >> 4) & 0x0F0F0F0Fu;
                  la = (la | (la >> 4)) & 0x00FF00FFu; la = (la | (la >> 8)) & 0xFFFFu; lb = (lb | (lb >> 4)) & 0x00FF00FFu; lb = (lb | (lb >> 8)) & 0xFFFFu;
                  ha = (ha | (ha >> 4)) & 0x00FF00FFu; ha = (ha | (ha >> 8)) & 0xFFFFu; hb = (hb | (hb >> 4)) & 0x00FF00FFu; hb = (hb | (hb >> 8)) & 0xFFFFu;
                  u32x2 hw; hw.x = ha | (hb << 16); hw.y = (la | (lb << 16)) ^ 0x88888888u;
                  *(LAS u32x2*)(HDW + 2 * pi) = hw; }
              LDS_WAIT();
              const int dr = lane3_ >> 3, dP = lane3_ & 7;
              const unsigned goff0 = 16u * (unsigned)(dP ^ (dr >> 1)), goff1 = 16u * (unsigned)(dP ^ (4 + (dr >> 1)));
              const int g4 = lane3_ >> 4, q16 = lane3_ & 15;
              const unsigned trb = (unsigned)((q16 >> 3) * 1024 + (q16 & 7) * 128 + 8 * (g4 & 1));
              unsigned tra[4];
#pragma unroll
              for (int sl = 0; sl < 4; ++sl) tra[sl] = (unsigned)(__SIZE_TYPE__)RING + trb + 16u * (unsigned)((2 * sl + (g4 >> 1)) ^ (q16 >> 1));
#define VS_ISSUE(cc, ii, rb) do { const unsigned e0_ = E16[(ii) * 128 + 16 * (rb) + dr], e1_ = E16[(ii) * 128 + 16 * (rb) + 8 + dr]; \
                  const unsigned char* gb_ = (const unsigned char*)VB + (unsigned)(cc) * (16384u * 128u); \
                  __builtin_amdgcn_global_load_lds((const unsigned*)(gb_ + (e0_ * 128u + goff0)), (LAS unsigned*)(RING + (rb) * 2048), 16, 0, 0); \
                  __builtin_amdgcn_global_load_lds((const unsigned*)(gb_ + (e1_ * 128u + goff1)), (LAS unsigned*)(RING + (rb) * 2048 + 1024), 16, 0, 0); } while (0)
              float am2[TPW], ss2[TPW];
#pragma unroll
              for (int i = 0; i < TPW; ++i) { am2[i] = 0.f; ss2[i] = 0.f; }
              float bnd[TPW], scp[TPW];
#pragma unroll
              for (int i = 0; i < TPW; ++i) { bnd[i] = 1.25f * AM1[i]; scp[i] = bnd[i] > 0.f ? 127.0f / bnd[i] : 0.f; }
              LDS_WAIT();
#pragma unroll
              for (int rb = 0; rb < 7; ++rb) VS_ISSUE(0, 0, rb);
#pragma unroll 1
              for (int c = 0; c < 8; ++c) {
#pragma unroll
                  for (int i = 0; i < TPW; ++i) {
                      const unsigned xo_ = ((unsigned)(tb + i) * DM + 256u * (unsigned)c + 4u * (unsigned)lane3_) * 2u;
                      const u32x2 x1v = *(const u32x2*)((const char*)X1B + xo_);
                      int aH[4] = {0, 0, 0, 0}, aL[4] = {0, 0, 0, 0};
#pragma unroll
                      for (int rb = 0; rb < 8; ++rb) {
                          const int nrb = (rb + 7) & 7, ni = i + ((rb + 7) >> 3);
                          if (ni < TPW) { VS_ISSUE(c, ni, nrb); } else { const int cn = (c < 7) ? c + 1 : 7, in_ = (c < 7) ? 0 : 7; VS_ISSUE(cn, in_, nrb); }
                          asm volatile("s_waitcnt vmcnt(14)" ::: "memory");
                          const u32x4 hd = *(const LAS u32x4*)(HDW + (i * 8 + rb) * 4);
                          i32x2 w[4];
#pragma unroll
                          for (int sl = 0; sl < 4; ++sl) asm volatile("ds_read_b64_tr_b4 %0, %1 offset:%2" : "=v"(w[sl]) : "v"(tra[sl]), "i"(rb * 2048) : "memory");
                          asm volatile("s_waitcnt lgkmcnt(0)" : "+v"(w[0]), "+v"(w[1]), "+v"(w[2]), "+v"(w[3]) :: "memory");
#pragma unroll
                          for (int sl = 0; sl < 4; ++sl) { aH[sl] = __builtin_amdgcn_sdot8(w[sl].x, (int)hd.x, aH[sl], false); aH[sl] = __builtin_amdgcn_sdot8(w[sl].y, (int)hd.z, aH[sl], false);
                              aL[sl] = __builtin_amdgcn_sdot8(w[sl].x, (int)hd.y, aL[sl], false); aL[sl] = __builtin_amdgcn_sdot8(w[sl].y, (int)hd.w, aL[sl], false); }
                      }
                      const float sh = SH[i], sq = SQH[i];
                      float fo[4];
#pragma unroll
                      for (int sl = 0; sl < 4; ++sl) { const unsigned xw_ = (sl < 2) ? x1v.x : x1v.y; const float f = ((sl & 1) ? bfhi(xw_) : bflo(xw_)) + sh * ((float)((aH[sl] << 4) + aL[sl]) + sq);
                          am2[i] = fmaxf(am2[i], fabsf(f)); ss2[i] += f * f; fo[sl] = f; }
                      { u32x2 xw2; xw2.x = pk2(fo[0], fo[1]); xw2.y = pk2(fo[2], fo[3]); *(u32x2*)((char*)X2B + xo_) = xw2;
                        *(unsigned*)(X2Q + (xo_ >> 1)) = q8x4(fo[0] * scp[i], fo[1] * scp[i], fo[2] * scp[i], fo[3] * scp[i]); }
                  }
              }
#undef VS_ISSUE
              unsigned viol = 0u; float amx[TPW];
#pragma unroll
              for (int i = 0; i < TPW; ++i) { float am = am2[i];
                  am = fmaxf(am, dppf<DPP_X1>(am)); am = fmaxf(am, dppf<DPP_X2>(am)); am = fmaxf(am, dppf<DPP_HMIR>(am)); am = fmaxf(am, dppf<DPP_MIR>(am));
                  am = fmaxf(am, __shfl_xor(am, 16)); am = fmaxf(am, __shfl_xor(am, 32));
                  const float ssum = wave_sum(ss2[i]); const bool v_ = am > bnd[i]; const float rng = v_ ? am : bnd[i];
                  if (lane3_ == 0) XS2[tb + i] = (1.0f / sqrtf(ssum * (1.0f / DM) + EPS)) * rng * (1.0f / 127.0f);
                  amx[i] = am; viol |= v_ ? (1u << i) : 0u; }
              if (viol) { asm volatile("s_waitcnt vmcnt(0)" ::: "memory");
#pragma unroll
                  for (int i = 0; i < TPW; ++i) if (viol & (1u << i)) { const float s_ = amx[i] > 0.f ? 127.0f / amx[i] : 0.f; u32x4 p[4], o8[2];
#pragma unroll
                      for (int q = 0; q < 4; ++q) p[q] = *(const u32x4*)((const char*)X2B + ((unsigned)(tb + i) * DM + 32u * (unsigned)lane3_) * 2u + 16 * q);
#pragma unroll
                      for (int h = 0; h < 2; ++h) { const u32x4 p0 = p[2 * h], p1 = p[2 * h + 1];
                          o8[h][0] = q8x4(bflo(p0.x) * s_, bfhi(p0.x) * s_, bflo(p0.y) * s_, bfhi(p0.y) * s_); o8[h][1] = q8x4(bflo(p0.z) * s_, bfhi(p0.z) * s_, bflo(p0.w) * s_, bfhi(p0.w) * s_);
                          o8[h][2] = q8x4(bflo(p1.x) * s_, bfhi(p1.x) * s_, bflo(p1.y) * s_, bfhi(p1.y) * s_); o8[h][3] = q8x4(bflo(p1.z) * s_, bfhi(p1.z) * s_, bflo(p1.w) * s_, bfhi(p1.w) * s_); }
                      u32x4* dst = (u32x4*)(X2Q + ((unsigned)(tb + i) * DM + 32u * (unsigned)lane3_)); dst[0] = o8[0]; dst[1] = o8[1]; } }
            }
        }
    }
    SEAM(7);

    if (IN(8)) {
        PH_LOCALS
        bf16_t* X2B = WSP(bf16_t, WS_X2B); unsigned char* X2Q = WSP(unsigned char, WS_X2Q); unsigned char* WGQ = WSP(unsigned char, WS_WGQ); bf16_t* PE = WSP(bf16_t, WS_XB); float* XS2 = WSP(float, WS_XS2);
        const float* CMAXF = WSP(float, WS_CMAX);
        bf16_t* PB = WSP(bf16_t, WS_PB); bf16_t* WPLET = WSP(bf16_t, WS_WPLET); unsigned char* G8 = WSP(unsigned char, WS_G8);
        { pg8::Gemm g{X2Q, WGQ, DM, DM, DM, 0}; pg8::StaticOrder S; S.init(T, DM, G, bx);
          pg8::Epi8a E{G8, XS2, CMAXF + W_IN};
          pg8::gemm_phase<pg8::Epi8a, pg8::StaticOrder, true>(L, g, S, E, tid, wave); }
        { pg8::Gemm g{PB, WPLET, 512, 512, 512, 0}; pg8::StaticOrder S; S.init(T, DM, G, bx);
          pg8::Epi8b E{out, X2B, G8};
          pg8::gemm_phase<pg8::Epi8b, pg8::StaticOrder>(L, g, S, E, tid, wave); }
    }
#undef IN
#undef SEAM
}

extern "C" void kernel_launch(void* const* d_in, const int* in_sizes, int n_in, void* d_out, int out_size, void* d_ws, size_t ws_size, hipStream_t stream) {
    static int grid = 0;
    if (grid == 0) {
        if (n_in != 18 || in_sizes[0] != T * DM || out_size != T * DM || ws_size < WS_END) {
            fprintf(stderr, "kernel_launch: unexpected shapes: n_in %d in0 %d out %d ws %zu (need %zu); nothing launched\n", n_in, n_in > 0 ? in_sizes[0] : -1, out_size, ws_size, (size_t)WS_END); grid = -1; return; }
        int dev = 0, cus = 0, per_cu = 0;
        if (hipGetDevice(&dev) != hipSuccess || hipDeviceGetAttribute(&cus, hipDeviceAttributeMultiprocessorCount, dev) != hipSuccess) { fprintf(stderr, "kernel_launch: device query failed\n"); grid = -1; return; }
        if (hipFuncSetAttribute((const void*)mega_fwd, hipFuncAttributeMaxDynamicSharedMemorySize, LDS_BYTES) != hipSuccess) { fprintf(stderr, "kernel_launch: hipFuncSetAttribute failed\n"); grid = -1; return; }
        if (hipOccupancyMaxActiveBlocksPerMultiprocessor(&per_cu, (const void*)mega_fwd, NW * 64, LDS_BYTES) != hipSuccess || per_cu < 1) { fprintf(stderr, "kernel_launch: occupancy query says %d blocks/CU\n", per_cu); (void)hipGetLastError(); grid = -1; return; }
        grid = cus;
    }
    if (grid < 0) return;
    if (hipMemsetAsync((char*)d_ws + WS_CTL, 0, CTL_BYTES, stream) != hipSuccess) { fprintf(stderr, "kernel_launch: hipMemsetAsync failed\n"); return; }
    Args a{};
    for (int i = 0; i < 18; ++i) a.in[i] = (const float*)d_in[i];
    a.out = (float*)d_out; a.ws = (unsigned char*)d_ws;
    constexpr int NPH = 9;
    a.ph_lo = 0; a.ph_hi = NPH;
    { void* kargs[] = {&a}; hipError_t e = hipLaunchCooperativeKernel((void*)mega_fwd, dim3(grid), dim3(NW * 64), kargs, LDS_BYTES, stream);
      if (e != hipSuccess) fprintf(stderr, "kernel_launch: cooperative launch failed: %s (grid %d)\n", hipGetErrorString(e), grid); }
}
```

```cpp
#include <hip/hip_runtime.h>
#include <cstdio>
#include <cstdint>


#define LAS __attribute__((address_space(3)))
typedef unsigned short bf16_t;
typedef short bf16x8 __attribute__((ext_vector_type(8)));
typedef float f32x4 __attribute__((ext_vector_type(4)));
typedef float f32x2 __attribute__((ext_vector_type(2)));
typedef float f32x16 __attribute__((ext_vector_type(16)));
typedef unsigned u32x4 __attribute__((ext_vector_type(4)));
typedef unsigned u32x2 __attribute__((ext_vector_type(2)));
typedef int i32x2 __attribute__((ext_vector_type(2)));
typedef short s16x4 __attribute__((ext_vector_type(4)));
typedef int i32x4 __attribute__((ext_vector_type(4)));
typedef _Float16 h2_t __attribute__((ext_vector_type(2)));
typedef __bf16 bf16x2_t __attribute__((ext_vector_type(2)));

constexpr int T = 16384, DM = 2048, SEQ = 4096;
constexpr int OFF_Q = 0, OFF_K = 1024, OFF_V = 1280, OFF_CH = 1536, OFF_CB = 2560, OFF_CC = 3584, OFF_GA = 4608, OFF_GC = 6656, W_IN = 8704;
constexpr float EPS = 1e-6f;
constexpr int NW = 8;

constexpr size_t MiB = 1u << 20;
constexpr size_t WS_XS1 = 0;
constexpr size_t WS_XS2 = 64 * 1024;
constexpr size_t WS_SU = 192 * 1024;
constexpr size_t WS_XD = 168 * MiB;
constexpr size_t WS_SV = 128 * 1024;
constexpr size_t WS_SSQ = 1 * MiB;
constexpr size_t WS_KEYBD = 3 * MiB;
constexpr size_t WS_WPLET = 4 * MiB;
constexpr size_t WS_PB = 5 * MiB;
constexpr size_t WS_WGQ = 13 * MiB;
constexpr size_t WS_WINQ = 21 * MiB;
constexpr size_t WS_W3AT = 55 * MiB;
constexpr size_t WS_WOUTT = 63 * MiB;
constexpr size_t WS_WQP = 71 * MiB;
constexpr size_t WS_WQKT = 79 * MiB;
constexpr size_t WS_X2B = 21 * MiB;
constexpr size_t WS_UB = 87 * MiB;
constexpr size_t WS_X2Q = 119 * MiB;
constexpr size_t WS_VB = 151 * MiB;
constexpr size_t WS_XB = 215 * MiB;
constexpr size_t WS_SGA = 279 * MiB;
constexpr size_t WS_Q = 343 * MiB;
constexpr size_t WS_KV = 375 * MiB;
constexpr size_t WS_PROD = 391 * MiB;
constexpr size_t WS_CB = 423 * MiB;
constexpr size_t WS_SGC = 455 * MiB;
constexpr size_t WS_G8 = 487 * MiB;
constexpr size_t WS_MERGED = WS_Q;
constexpr size_t WS_SCORES = WS_Q;
constexpr size_t WS_CTL = 519 * MiB;
constexpr size_t CTL_BYTES = 65536;
constexpr size_t WS_CMAX = WS_CTL + 16384;
constexpr size_t WS_END = 519 * MiB + 65536;

constexpr int LDS_BYTES = 163840;

#define LDS_WAIT() asm volatile("s_waitcnt lgkmcnt(0)" ::: "memory")

__device__ __forceinline__ unsigned pkh2(float lo, float hi) { f32x2 v = {lo, hi}; h2_t b = __builtin_convertvector(v, h2_t); return __builtin_bit_cast(unsigned, b); }
__device__ __forceinline__ unsigned pk2(float lo, float hi) { f32x2 v = {lo, hi}; bf16x2_t b = __builtin_convertvector(v, bf16x2_t); return __builtin_bit_cast(unsigned, b); }
__device__ __forceinline__ float bflo(unsigned w) { return __uint_as_float(w << 16); }
__device__ __forceinline__ float bfhi(unsigned w) { return __uint_as_float(w & 0xffff0000u); }
__device__ __forceinline__ float bf2f(bf16_t h) { return __uint_as_float((unsigned)h << 16); }
__device__ __forceinline__ float sig255_(float t) { return __builtin_amdgcn_rcpf(__builtin_fmaf(__builtin_amdgcn_exp2f(t), 1.0f / 255.0f, 1.0f / 255.0f)); }
__device__ __forceinline__ float sigmoidf_(float x) { return __builtin_amdgcn_rcpf(1.0f + __builtin_amdgcn_exp2f(-1.4426950408889634f * x)); }
__device__ __forceinline__ float wave_sum(float v) {
#pragma unroll
    for (int o = 1; o < 64; o <<= 1) v += __shfl_xor(v, o);
    return v;
}

namespace pg8 {
constexpr int BM = 256, BK = 64, HALF = 128, HTB = HALF * BK * 2, STAGE_BYTES = 8 * HTB, NXCD = 8, WGM = 8;
__host__ __device__ __forceinline__ int lds_byte(int r, int c) { const int st = (r >> 4) * 2 + (c >> 5), rr = r & 15, cc = c & 31, ob = rr * 64 + cc * 2; return st * 1024 + (ob ^ (((ob >> 9) & 1) << 5)); }
__host__ __device__ __forceinline__ void stage_rc(int b, int& R, int& C) { const int st = b / 1024, sb = b % 1024, swz = sb ^ (((sb >> 9) & 1) << 5); R = (st >> 1) * 16 + swz / 64; C = (st & 1) * 32 + (swz % 64) / 2; }
__host__ __device__ __forceinline__ int perm32(int rho) { const int n = rho >> 4, i = rho & 15; return 8 * (i >> 2) + 4 * n + (i & 3); }

struct Unit { int pm, pn; };
struct Gemm { const void* A; const void* Bt; int Kb, lda_b, ldb_b, b_koff_b; };

struct StaticOrder {
    int nM, nN, nwg, G, c;
    __device__ void init(int M, int N, int G_, int c_) { nM = M / BM; nN = N / BM; nwg = nM * nN; G = G_; c = c_; }
    __device__ bool next(int i, Unit& u) const {
        const long L = (long)i * G + c; if (L >= nwg) return false;
        int wgid = (int)L; { const int q = nwg / NXCD, r = nwg % NXCD, xcd = wgid % NXCD, off = wgid / NXCD; wgid = (xcd < r ? xcd * (q + 1) : r * (q + 1) + (xcd - r) * q) + off; }
        const int nig = WGM * nN, gid = wgid / nig, fm = gid * WGM, gsz = (nM - fm) < WGM ? (nM - fm) : WGM;
        u.pm = fm + ((wgid % nig) % gsz); u.pn = (wgid % nig) / gsz; return true;
    }
};

typedef f32x4 Acc[2][2][4][2];

struct EpiBf16 {
    static constexpr bool PERM = true, HAS_MID = false;
    bf16_t* O; int ldc;
    __device__ __forceinline__ void mid(Acc& acc, const Unit& u, int wr, int wc, int fr, int fq) const {}
    __device__ __forceinline__ void operator()(Acc& acc, const Unit& u, int wr, int wc, int fr, int fq) const {
        const int row0 = u.pm * BM + wr * 64 + fr, col0 = u.pn * BM + wc * 32 + 8 * fq;
#pragma unroll
        for (int ai = 0; ai < 2; ++ai)
#pragma unroll
            for (int m = 0; m < 4; ++m) { bf16_t* rowp = O + (size_t)(row0 + ai * HALF + m * 16) * ldc + col0;
#pragma unroll
                for (int bj = 0; bj < 2; ++bj) { const f32x4 v0 = acc[ai][bj][m][0], v1 = acc[ai][bj][m][1];
                    u32x4 w; w.x = pk2(v0[0], v0[1]); w.y = pk2(v0[2], v0[3]); w.z = pk2(v1[0], v1[1]); w.w = pk2(v1[2], v1[3]);
                    *(u32x4*)(rowp + bj * HALF) = w; } }
    }
};
struct EpiF16 {
    static constexpr bool PERM = true, HAS_MID = false;
    unsigned short* O; int ldc;
    __device__ __forceinline__ void mid(Acc& acc, const Unit& u, int wr, int wc, int fr, int fq) const {}
    __device__ __forceinline__ void operator()(Acc& acc, const Unit& u, int wr, int wc, int fr, int fq) const {
        const int row0 = u.pm * BM + wr * 64 + fr, col0 = u.pn * BM + wc * 32 + 8 * fq;
#pragma unroll
        for (int ai = 0; ai < 2; ++ai)
#pragma unroll
            for (int m = 0; m < 4; ++m) { unsigned short* rowp = O + (size_t)(row0 + ai * HALF + m * 16) * ldc + col0;
#pragma unroll
                for (int bj = 0; bj < 2; ++bj) { const f32x4 v0 = acc[ai][bj][m][0], v1 = acc[ai][bj][m][1];
                    u32x4 w; w.x = pkh2(v0[0], v0[1]); w.y = pkh2(v0[2], v0[3]); w.z = pkh2(v1[0], v1[1]); w.w = pkh2(v1[2], v1[3]);
                    *(u32x4*)(rowp + bj * HALF) = w; } }
    }
};
struct EpiF32 {
    static constexpr bool PERM = false, HAS_MID = false;
    float* C; int ldc;
    __device__ __forceinline__ void mid(Acc& acc, const Unit& u, int wr, int wc, int fr, int fq) const {}
    __device__ __forceinline__ void operator()(Acc& acc, const Unit& u, int wr, int wc, int fr, int fq) const {
        const int row0 = u.pm * BM + wr * 64 + fr, col0 = u.pn * BM + wc * 32 + 4 * fq;
#pragma unroll
        for (int ai = 0; ai < 2; ++ai)
#pragma unroll
            for (int m = 0; m < 4; ++m) { float* rowp = C + (size_t)(row0 + ai * HALF + m * 16) * ldc + col0;
#pragma unroll
                for (int bj = 0; bj < 2; ++bj)
#pragma unroll
                    for (int n = 0; n < 2; ++n) *(f32x4*)(rowp + bj * HALF + n * 16) = acc[ai][bj][m][n]; }
    }
};
__device__ __forceinline__ size_t frag_off(int pm, int pn, int wr, int wc, int fr, int fq, int k) { return (size_t)(pm * 8 + pn) * 65536u + (size_t)((((k * 8 + wr * 4 + wc) * 64) + fq * 16 + fr) * 16); }
struct Epi1 {
    static constexpr bool PERM = true, HAS_MID = false;
    bf16_t *Q, *KV, *PROD, *CB; unsigned char *SGA, *SGC; const float* rstd; const float* cmax;
    __device__ __forceinline__ void mid(Acc& acc, const Unit& u, int wr, int wc, int fr, int fq) const {}
    __device__ __forceinline__ void operator()(Acc& acc, const Unit& u, int wr, int wc, int fr, int fq) const {
        const int row0 = u.pm * BM + wr * 64 + fr, cw = wc * 32 + 8 * fq, pn = u.pn;
        bf16_t* base; int ldc, col0, mode = 0;
        if (pn < 4) { base = Q; ldc = 1024; col0 = pn * 256 + cw; }
        else if (pn == 4) { base = KV; ldc = 512; col0 = cw; }
        else if (pn == 5) { base = KV; ldc = 512; col0 = 256 + cw; }
        else if (pn < 14) { base = PROD; ldc = 1024; col0 = (pn - 6) * 128 + cw; mode = 1; }
        else if (pn < 18) { base = CB; ldc = 1024; col0 = (pn - 14) * 256 + cw; }
        else if (pn < 26) { base = (bf16_t*)SGA; ldc = 1024; col0 = (pn - 18) * 256 + cw; mode = 2; }
        else { base = (bf16_t*)SGC; ldc = 1024; col0 = (pn - 26) * 256 + cw; mode = 2; }
        f32x4 cs[2][2];
#pragma unroll
        for (int bj = 0; bj < 2; ++bj)
#pragma unroll
            for (int n = 0; n < 2; ++n) cs[bj][n] = *(const f32x4*)(cmax + pn * 256 + bj * HALF + cw + 4 * n) * (1.0f / 127.0f);
#pragma unroll
        for (int ai = 0; ai < 2; ++ai)
#pragma unroll
            for (int m = 0; m < 4; ++m) { const int row = row0 + ai * HALF + m * 16; const float r = rstd[row]; bf16_t* rowp = base + (size_t)row * ldc + col0;
                if (mode == 1) {
                    const f32x4 v0 = (acc[ai][0][m][0] * cs[0][0] * r) * (acc[ai][1][m][0] * cs[1][0] * r), v1 = (acc[ai][0][m][1] * cs[0][1] * r) * (acc[ai][1][m][1] * cs[1][1] * r);
                    u32x4 w; w.x = pk2(v0[0], v0[1]); w.y = pk2(v0[2], v0[3]); w.z = pk2(v1[0], v1[1]); w.w = pk2(v1[2], v1[3]);
                    *(u32x4*)rowp = w;
                } else if (mode == 2) { u32x4 w8;
#pragma unroll
                    for (int bj = 0; bj < 2; ++bj) { const float rn = r * -1.4426950408889634f; const f32x4 v0 = acc[ai][bj][m][0] * cs[bj][0] * rn, v1 = acc[ai][bj][m][1] * cs[bj][1] * rn; unsigned q0 = 0u, q1 = 0u;
#pragma unroll
                        for (int j = 0; j < 4; ++j) { q0 = __builtin_amdgcn_cvt_pk_u8_f32(fmaxf(sig255_(v0[j]), 1.0f), j, q0); q1 = __builtin_amdgcn_cvt_pk_u8_f32(fmaxf(sig255_(v1[j]), 1.0f), j, q1); }
                        w8[2 * bj] = q0; w8[2 * bj + 1] = q1; }
                    *(u32x4*)((unsigned char*)base + frag_off(u.pm, (pn < 26) ? pn - 18 : pn - 26, wr, wc, fr, fq, ai * 4 + m)) = w8;
                } else {
#pragma unroll
                    for (int bj = 0; bj < 2; ++bj) { f32x4 v0 = acc[ai][bj][m][0] * cs[bj][0] * r, v1 = acc[ai][bj][m][1] * cs[bj][1] * r;
                        u32x4 w; w.x = pk2(v0[0], v0[1]); w.y = pk2(v0[2], v0[3]); w.z = pk2(v1[0], v1[1]); w.w = pk2(v1[2], v1[3]);
                        *(u32x4*)(rowp + bj * HALF) = w; }
                } }
    }
};
struct Epi3a {
    static constexpr bool PERM = true, HAS_MID = true;
    const unsigned char *SGA, *SGC; bf16_t* O;
    __device__ __forceinline__ void mid(Acc& acc, const Unit& u, int wr, int wc, int fr, int fq) const {
        u32x4 ga[2][4], gc[2][4];
#pragma unroll
        for (int ai = 0; ai < 2; ++ai)
#pragma unroll
            for (int m = 0; m < 4; ++m) { const size_t fo = frag_off(u.pm, u.pn, wr, wc, fr, fq, ai * 4 + m); ga[ai][m] = *(const u32x4*)(SGA + fo); gc[ai][m] = *(const u32x4*)(SGC + fo); }
#pragma unroll
        for (int ai = 0; ai < 2; ++ai)
#pragma unroll
            for (int m = 0; m < 4; ++m)
#pragma unroll
                for (int bj = 0; bj < 2; ++bj) { const unsigned ax = ga[ai][m][2 * bj], ay = ga[ai][m][2 * bj + 1], cx = gc[ai][m][2 * bj], cy = gc[ai][m][2 * bj + 1]; f32x4 r0, r1;
#pragma unroll
                    for (int j = 0; j < 4; ++j) { r0[j] = (float)((ax >> (8 * j)) & 0xffu) * __builtin_amdgcn_rcpf((float)((cx >> (8 * j)) & 0xffu)); r1[j] = (float)((ay >> (8 * j)) & 0xffu) * __builtin_amdgcn_rcpf((float)((cy >> (8 * j)) & 0xffu)); }
                    acc[ai][bj][m][0] *= r0; acc[ai][bj][m][1] *= r1; }
    }
    __device__ __forceinline__ void operator()(Acc& acc, const Unit& u, int wr, int wc, int fr, int fq) const {
        const int row0 = u.pm * BM + wr * 64 + fr, col0 = u.pn * BM + wc * 32 + 8 * fq;
        u32x4 gc[2][4];
#pragma unroll
        for (int ai = 0; ai < 2; ++ai)
#pragma unroll
            for (int m = 0; m < 4; ++m) gc[ai][m] = *(const u32x4*)(SGC + frag_off(u.pm, u.pn, wr, wc, fr, fq, ai * 4 + m));
#pragma unroll
        for (int ai = 0; ai < 2; ++ai)
#pragma unroll
            for (int m = 0; m < 4; ++m) { const size_t off = (size_t)(row0 + ai * HALF + m * 16) * DM + col0;
#pragma unroll
                for (int bj = 0; bj < 2; ++bj) { const unsigned cx = gc[ai][m][2 * bj], cy = gc[ai][m][2 * bj + 1]; const f32x4 v0 = acc[ai][bj][m][0] * (1.0f / 255.0f), v1 = acc[ai][bj][m][1] * (1.0f / 255.0f);
                    u32x4 w; w.x = pk2(v0[0] * (float)(cx & 0xffu), v0[1] * (float)((cx >> 8) & 0xffu)); w.y = pk2(v0[2] * (float)((cx >> 16) & 0xffu), v0[3] * (float)(cx >> 24));
                    w.z = pk2(v1[0] * (float)(cy & 0xffu), v1[1] * (float)((cy >> 8) & 0xffu)); w.w = pk2(v1[2] * (float)((cy >> 16) & 0xffu), v1[3] * (float)(cy >> 24));
                    *(u32x4*)(O + off + bj * HALF) = w; } }
    }
};
struct Epi3b {
    static constexpr bool PERM = true, HAS_MID = false;
    const float* X; bf16_t* XB; float* SSQ;
    __device__ __forceinline__ void mid(Acc& acc, const Unit& u, int wr, int wc, int fr, int fq) const {}
    __device__ __forceinline__ void operator()(Acc& acc, const Unit& u, int wr, int wc, int fr, int fq) const {
        const int row0 = u.pm * BM + wr * 64 + fr, col0 = u.pn * BM + wc * 32 + 8 * fq;
#pragma unroll
        for (int ai = 0; ai < 2; ++ai) {
            f32x4 xv[4][2][2];
#pragma unroll
            for (int m = 0; m < 4; ++m) { const size_t off = (size_t)(row0 + ai * HALF + m * 16) * DM + col0;
#pragma unroll
                for (int bj = 0; bj < 2; ++bj)
#pragma unroll
                    for (int n = 0; n < 2; ++n) xv[m][bj][n] = *(const f32x4*)(X + off + bj * HALF + n * 4); }
            asm volatile("" ::: "memory");
#pragma unroll
            for (int m = 0; m < 4; ++m) { const int row = row0 + ai * HALF + m * 16; const size_t off = (size_t)row * DM + col0;
#pragma unroll
                for (int bj = 0; bj < 2; ++bj) { const f32x4 o0 = xv[m][bj][0] + acc[ai][bj][m][0], o1 = xv[m][bj][1] + acc[ai][bj][m][1];
                    u32x4 w; w.x = pk2(o0[0], o0[1]); w.y = pk2(o0[2], o0[3]); w.z = pk2(o1[0], o1[1]); w.w = pk2(o1[2], o1[3]);
                    *(u32x4*)(XB + off + bj * HALF) = w;
                    } }
            asm volatile("" ::: "memory");
        }
    }
};
struct Epi8a {
    static constexpr bool PERM = true, HAS_MID = false;
    unsigned char* G; const float* rstd; const float* cmax;
    __device__ __forceinline__ void mid(Acc& acc, const Unit& u, int wr, int wc, int fr, int fq) const {}
    __device__ __forceinline__ void operator()(Acc& acc, const Unit& u, int wr, int wc, int fr, int fq) const {
        const int row0 = u.pm * BM + wr * 64 + fr, cw = wc * 32 + 8 * fq, col0 = u.pn * BM + cw;
        f32x4 cs[2][2];
#pragma unroll
        for (int bj = 0; bj < 2; ++bj)
#pragma unroll
            for (int n = 0; n < 2; ++n) cs[bj][n] = *(const f32x4*)(cmax + col0 + bj * HALF + 4 * n) * (1.0f / 127.0f);
#pragma unroll
        for (int ai = 0; ai < 2; ++ai)
#pragma unroll
            for (int m = 0; m < 4; ++m) { const int row = row0 + ai * HALF + m * 16; const float r = rstd[row];
                u32x4 w8;
#pragma unroll
                for (int bj = 0; bj < 2; ++bj) { const float rn = r * -1.4426950408889634f; const f32x4 v0 = acc[ai][bj][m][0] * cs[bj][0] * rn, v1 = acc[ai][bj][m][1] * cs[bj][1] * rn; unsigned q0 = 0u, q1 = 0u;
#pragma unroll
                    for (int j = 0; j < 4; ++j) { q0 = __builtin_amdgcn_cvt_pk_u8_f32(sig255_(v0[j]), j, q0); q1 = __builtin_amdgcn_cvt_pk_u8_f32(sig255_(v1[j]), j, q1); }
                    w8[2 * bj] = q0; w8[2 * bj + 1] = q1; }
                *(u32x4*)(G + frag_off(u.pm, u.pn, wr, wc, fr, fq, ai * 4 + m)) = w8; }
    }
};
struct Epi8b {
    static constexpr bool PERM = true, HAS_MID = false;
    float* OUT; const bf16_t* X2; const unsigned char* G;
    __device__ __forceinline__ void mid(Acc& acc, const Unit& u, int wr, int wc, int fr, int fq) const {}
    __device__ __forceinline__ void operator()(Acc& acc, const Unit& u, int wr, int wc, int fr, int fq) const {
        const int row0 = u.pm * BM + wr * 64 + fr, col0 = u.pn * BM + wc * 32 + 8 * fq;
#pragma unroll
        for (int ai = 0; ai < 2; ++ai) {
            u32x4 xq[4][2]; u32x4 gq[4];
#pragma unroll
            for (int m = 0; m < 4; ++m) { const size_t off = (size_t)(row0 + ai * HALF + m * 16) * DM + col0;
#pragma unroll
                for (int bj = 0; bj < 2; ++bj) xq[m][bj] = *(const u32x4*)(X2 + off + bj * HALF);
                gq[m] = *(const u32x4*)(G + frag_off(u.pm, u.pn, wr, wc, fr, fq, ai * 4 + m)); }
            asm volatile("" ::: "memory");
#pragma unroll
            for (int m = 0; m < 4; ++m) { const size_t off = (size_t)(row0 + ai * HALF + m * 16) * DM + col0;
#pragma unroll
                for (int bj = 0; bj < 2; ++bj) { const u32x4 xb = xq[m][bj]; u32x2 gb; gb.x = gq[m][2 * bj]; gb.y = gq[m][2 * bj + 1]; const f32x4 a0 = acc[ai][bj][m][0], a1 = acc[ai][bj][m][1]; f32x4 o0, o1;
                    o0[0] = bflo(xb.x) + a0[0] * ((float)(gb.x & 0xffu) * (1.0f / 255.0f)); o0[1] = bfhi(xb.x) + a0[1] * ((float)((gb.x >> 8) & 0xffu) * (1.0f / 255.0f));
                    o0[2] = bflo(xb.y) + a0[2] * ((float)((gb.x >> 16) & 0xffu) * (1.0f / 255.0f)); o0[3] = bfhi(xb.y) + a0[3] * ((float)(gb.x >> 24) * (1.0f / 255.0f));
                    o1[0] = bflo(xb.z) + a1[0] * ((float)(gb.y & 0xffu) * (1.0f / 255.0f)); o1[1] = bfhi(xb.z) + a1[1] * ((float)((gb.y >> 8) & 0xffu) * (1.0f / 255.0f));
                    o1[2] = bflo(xb.w) + a1[2] * ((float)((gb.y >> 16) & 0xffu) * (1.0f / 255.0f)); o1[3] = bfhi(xb.w) + a1[3] * ((float)(gb.y >> 24) * (1.0f / 255.0f));
                    *(f32x4*)(OUT + off + bj * HALF) = o0; *(f32x4*)(OUT + off + bj * HALF + 4) = o1; } }
            asm volatile("" ::: "memory");
        }
    }
};
struct Epi8 {
    static constexpr bool PERM = false, HAS_MID = false;
    float* OUT; const bf16_t* X2; const bf16_t* PE; const float* rstd; const float* cmax;
    __device__ __forceinline__ void mid(Acc& acc, const Unit& u, int wr, int wc, int fr, int fq) const {}
    __device__ __forceinline__ void operator()(Acc& acc, const Unit& u, int wr, int wc, int fr, int fq) const {
        const int row0 = u.pm * BM + wr * 64 + fr, col0 = u.pn * BM + wc * 32 + 4 * fq;
        f32x4 cs[2][2];
#pragma unroll
        for (int bj = 0; bj < 2; ++bj)
#pragma unroll
            for (int n = 0; n < 2; ++n) cs[bj][n] = *(const f32x4*)(cmax + col0 + bj * HALF + n * 16) * (1.0f / 127.0f);
#pragma unroll
        for (int ai = 0; ai < 2; ++ai) {
            u32x2 xq[4][2][2], pq[4][2][2]; float rr[4];
#pragma unroll
            for (int m = 0; m < 4; ++m) { const int row = row0 + ai * HALF + m * 16; const size_t off = (size_t)row * DM + col0; rr[m] = rstd[row];
#pragma unroll
                for (int bj = 0; bj < 2; ++bj)
#pragma unroll
                    for (int n = 0; n < 2; ++n) { const size_t o2 = off + bj * HALF + n * 16; xq[m][bj][n] = *(const u32x2*)(X2 + o2); pq[m][bj][n] = *(const u32x2*)(PE + o2); } }
            asm volatile("" ::: "memory");
#pragma unroll
            for (int m = 0; m < 4; ++m) { const int row = row0 + ai * HALF + m * 16; const size_t off = (size_t)row * DM + col0; const float r = rr[m];
#pragma unroll
                for (int bj = 0; bj < 2; ++bj)
#pragma unroll
                    for (int n = 0; n < 2; ++n) { const size_t o2 = off + bj * HALF + n * 16; const u32x2 xb2 = xq[m][bj][n], pe = pq[m][bj][n];
                        const f32x4 a = acc[ai][bj][m][n] * cs[bj][n]; f32x4 o;
                        o[0] = bflo(xb2.x) + bflo(pe.x) * sigmoidf_(r * a[0]); o[1] = bfhi(xb2.x) + bfhi(pe.x) * sigmoidf_(r * a[1]);
                        o[2] = bflo(xb2.y) + bflo(pe.y) * sigmoidf_(r * a[2]); o[3] = bfhi(xb2.y) + bfhi(pe.y) * sigmoidf_(r * a[3]);
                        *(f32x4*)(OUT + o2) = o; } }
            asm volatile("" ::: "memory");
        }
    }
};

template <class Epi, class Sched, bool I8 = false>
__device__ __forceinline__ void gemm_phase(LAS unsigned char* lds, const Gemm g, const Sched& S, const Epi& E, const int tid, const int wid) {
    const int lane = tid & 63, wr = wid >> 2, wc = wid & 3, fr = lane & 15, fq = lane >> 4;
    int K_ = g.Kb; asm volatile("" : "+s"(K_));
    const int nt = K_ / (BK * 2);
    unsigned voffA[2], voffB[2];
#pragma unroll
    for (int i = 0; i < 2; ++i) { int R, C; stage_rc(tid * 16 + i * 8192, R, C); const int Rb = Epi::PERM ? ((R & ~31) + perm32(R & 31)) : R;
        voffA[i] = (unsigned)(R * g.lda_b + C * 2); voffB[i] = (unsigned)(Rb * g.ldb_b + C * 2); }
    const size_t kstep = (size_t)(BK * 2);
    const size_t hstepA = (size_t)HALF * g.lda_b, hstepB = (size_t)HALF * g.ldb_b;
    const size_t tstepA = 2 * hstepA, tstepB = 2 * hstepB;
    const unsigned ldsw = (unsigned)wid * 1024u;
    const int aoff = lds_byte(wr * 64 + fr, fq * 8), boff = lds_byte(wc * 32 + fr, fq * 8);
#define PG8_SA(b, h) (((b) * 2 + (h)) * HTB)
#define PG8_SB(b, h) ((4 + (b) * 2 + (h)) * HTB)
#define PG8_STAGE(bufoff, gbase, voff) do { _Pragma("unroll") for (int _i = 0; _i < 2; ++_i) \
        __builtin_amdgcn_global_load_lds((const unsigned*)((const char*)(gbase) + (voff)[_i]), (LAS unsigned*)(lds + (bufoff) + ldsw + _i * 8192), 16, 0, 0); } while (0)
#define PG8_LDA(dst, b, h) do { _Pragma("unroll") for (int m = 0; m < 4; ++m) _Pragma("unroll") for (int k = 0; k < 2; ++k) dst[m][k] = *(const LAS bf16x8*)(lds + PG8_SA(b, h) + aoff + m * 2048 + k * 1024); } while (0)
#define PG8_LDB(dst, b, h) do { _Pragma("unroll") for (int n = 0; n < 2; ++n) _Pragma("unroll") for (int k = 0; k < 2; ++k) dst[n][k] = *(const LAS bf16x8*)(lds + PG8_SB(b, h) + boff + n * 2048 + k * 1024); } while (0)
#define PG8_MMA(ai, bj, At, Bt) do { __builtin_amdgcn_s_setprio(1); _Pragma("unroll") for (int m = 0; m < 4; ++m) _Pragma("unroll") for (int n = 0; n < 2; ++n) _Pragma("unroll") for (int k = 0; k < 2; ++k) { \
        if constexpr (I8) acc[ai][bj][m][n] = __builtin_bit_cast(f32x4, __builtin_amdgcn_mfma_i32_16x16x64_i8(__builtin_bit_cast(i32x4, Bt[n][k]), __builtin_bit_cast(i32x4, At[m][k]), __builtin_bit_cast(i32x4, acc[ai][bj][m][n]), 0, 0, 0)); \
        else acc[ai][bj][m][n] = __builtin_amdgcn_mfma_f32_16x16x32_bf16(Bt[n][k], At[m][k], acc[ai][bj][m][n], 0, 0, 0); } __builtin_amdgcn_s_setprio(0); } while (0)
#define PG8_WAIT_V(n) asm volatile("s_waitcnt vmcnt(" #n ")" ::: "memory")
#define PG8_WAIT_L(n) asm volatile("s_waitcnt lgkmcnt(" #n ")" ::: "memory")
#define PG8_BAR __builtin_amdgcn_s_barrier()
#define PG8_SCHED __builtin_amdgcn_sched_barrier(0)
#define PG8_BASEA(u) ((const char*)g.A + (size_t)(u).pm * tstepA)
#define PG8_BASEB(u) ((const char*)g.Bt + (size_t)(u).pn * tstepB + (size_t)(u).pm * (size_t)g.b_koff_b)
    Unit cur, nxt; int ui = 0;
    if (!S.next(0, cur)) return;
    Acc acc;
#pragma unroll
    for (int a = 0; a < 2; ++a)
#pragma unroll
        for (int b = 0; b < 2; ++b)
#pragma unroll
            for (int m = 0; m < 4; ++m)
#pragma unroll
                for (int n = 0; n < 2; ++n) acc[a][b][m][n] = (f32x4){0.f, 0.f, 0.f, 0.f};
    bf16x8 At[4][2], B0[2][2], B1[2][2];
    const char* cA = PG8_BASEA(cur); const char* cB = PG8_BASEB(cur);
    PG8_STAGE(PG8_SB(0, 0), cB, voffB); PG8_STAGE(PG8_SB(0, 1), cB + hstepB, voffB); PG8_STAGE(PG8_SA(0, 0), cA, voffA); PG8_STAGE(PG8_SA(0, 1), cA + hstepA, voffA);
    if (wr == 1) PG8_BAR;
    PG8_WAIT_V(2); PG8_BAR;
    PG8_STAGE(PG8_SB(1, 0), cB + kstep, voffB); PG8_STAGE(PG8_SA(1, 0), cA + kstep, voffA); PG8_STAGE(PG8_SB(1, 1), cB + hstepB + kstep, voffB);
    PG8_WAIT_V(6); PG8_BAR;
    for (;;) {
        const bool has_next = S.next(ui + 1, nxt);
        const char* nA = has_next ? PG8_BASEA(nxt) : cA; const char* nB = has_next ? PG8_BASEB(nxt) : cB;
        for (int t = 0; t < nt; t += 2) {
            if constexpr (Epi::HAS_MID) { if (t == (nt >> 1)) { int fq_ = fq; asm volatile("" : "+v"(fq_)); E.mid(acc, cur, wr, wc, fr, fq_); } }
            const bool last = (t == nt - 2);
            const char* a1 = cA + (size_t)(t + 1) * kstep;
            const char* a2 = last ? nA : cA + (size_t)(t + 2) * kstep; const char* b2 = last ? nB : cB + (size_t)(t + 2) * kstep;
            const char* a3 = a2 + kstep; const char* b3 = b2 + kstep;
            PG8_LDB(B0, 0, 0); PG8_LDB(B1, 0, 1); PG8_SCHED; PG8_LDA(At, 0, 0); PG8_STAGE(PG8_SA(1, 1), a1 + hstepA, voffA);
            PG8_WAIT_V(8); PG8_WAIT_L(0); PG8_BAR; PG8_MMA(0, 0, At, B0); PG8_MMA(0, 1, At, B1); PG8_BAR; PG8_SCHED;
            PG8_LDA(At, 0, 1); PG8_STAGE(PG8_SB(0, 0), b2, voffB); PG8_STAGE(PG8_SB(0, 1), b2 + hstepB, voffB); PG8_STAGE(PG8_SA(0, 0), a2, voffA);
            PG8_WAIT_V(8); PG8_WAIT_L(0); PG8_BAR; PG8_MMA(1, 0, At, B0); PG8_MMA(1, 1, At, B1); PG8_BAR; PG8_SCHED;
            PG8_LDB(B0, 1, 0); PG8_LDB(B1, 1, 1); PG8_SCHED; PG8_LDA(At, 1, 0); PG8_STAGE(PG8_SA(0, 1), a2 + hstepA, voffA);
            PG8_WAIT_V(8); PG8_WAIT_L(0); PG8_BAR; PG8_MMA(0, 0, At, B0); PG8_MMA(0, 1, At, B1); PG8_BAR; PG8_SCHED;
            PG8_LDA(At, 1, 1); PG8_STAGE(PG8_SB(1, 0), b3, voffB); PG8_STAGE(PG8_SB(1, 1), b3 + hstepB, voffB); PG8_STAGE(PG8_SA(1, 0), a3, voffA);
            PG8_WAIT_V(8); PG8_WAIT_L(0); PG8_BAR; PG8_MMA(1, 0, At, B0); PG8_MMA(1, 1, At, B1); PG8_BAR; PG8_SCHED;
        }
        if (wr == 0) PG8_BAR;
        if constexpr (I8) {
#pragma unroll
            for (int a = 0; a < 2; ++a)
#pragma unroll
                for (int b = 0; b < 2; ++b)
#pragma unroll
                    for (int m = 0; m < 4; ++m)
#pragma unroll
                        for (int n = 0; n < 2; ++n) { const i32x4 iv = __builtin_bit_cast(i32x4, acc[a][b][m][n]); acc[a][b][m][n] = (f32x4){(float)iv[0], (float)iv[1], (float)iv[2], (float)iv[3]}; } }
        { int fq_ = fq; asm volatile("" : "+v"(fq_)); E(acc, cur, wr, wc, fr, fq_); }
        if (!has_next) break;
#pragma unroll
        for (int a = 0; a < 2; ++a)
#pragma unroll
            for (int b = 0; b < 2; ++b)
#pragma unroll
                for (int m = 0; m < 4; ++m)
#pragma unroll
                    for (int n = 0; n < 2; ++n) acc[a][b][m][n] = (f32x4){0.f, 0.f, 0.f, 0.f};
        cur = nxt; cA = nA; cB = nB; ++ui;
        if (wr == 1) PG8_BAR;
    }
    PG8_WAIT_V(0);
    PG8_BAR;
#undef PG8_SA
#undef PG8_SB
#undef PG8_STAGE
#undef PG8_LDA
#undef PG8_LDB
#undef PG8_MMA
#undef PG8_WAIT_V
#undef PG8_WAIT_L
#undef PG8_BAR
#undef PG8_SCHED
#undef PG8_BASEA
#undef PG8_BASEB
}
}

namespace attn {
constexpr int D = 128, QBLK = 32, KVBLK = 64;
constexpr float SCALE = 0.088388347648318440f;
constexpr float THR = 8.f;
constexpr int LDQ = 1024, LDK = 512, LDO = 2048;
constexpr size_t SHM_V = KVBLK * D * 2, SHM_K = KVBLK * D * 2, SHM_ATTN = 2 * SHM_V + 2 * SHM_K + NW * 64 * 4;
#define KSWZ(row, colB) ((row) * 256 + ((colB) ^ (((row) & 7) << 4)))
#define SBAR() __builtin_amdgcn_sched_barrier(0)
__device__ __forceinline__ int crow(int r, int hi) { return (r & 3) + 8 * (r >> 2) + 4 * hi; }
__device__ __forceinline__ unsigned cvtpk(float lo, float hi) { unsigned r; asm volatile("v_cvt_pk_bf16_f32 %0, %1, %2" : "=v"(r) : "v"(lo), "v"(hi)); return r; }
__device__ __forceinline__ bf16x8 ld8(const bf16_t* p) { return *reinterpret_cast<const bf16x8*>(p); }

__device__ __forceinline__ void partialSM(f32x16& p0, f32x16& p1, float& m_reg, float& mn, float& alpha) {
  constexpr float C = SCALE * 1.4426950408889634f;
  float pmax = p0[0];
#pragma unroll
  for (int r = 1; r < 16; ++r) pmax = fmaxf(pmax, p0[r]);
#pragma unroll
  for (int r = 0; r < 16; ++r) pmax = fmaxf(pmax, p1[r]);
  { auto rr = __builtin_amdgcn_permlane32_swap(__float_as_uint(pmax), __float_as_uint(pmax), false, false);
    pmax = fmaxf(__uint_as_float(rr[0]), __uint_as_float(rr[1])); }
  if (__builtin_expect(__all(pmax - m_reg <= THR / SCALE), 1)) { mn = m_reg; alpha = 1.f; }
  else { mn = fmaxf(m_reg, pmax); alpha = __builtin_amdgcn_exp2f((m_reg - mn) * C); m_reg = mn; }
  float mnC = -mn * C;
#pragma unroll
  for (int r = 0; r < 16; ++r) p0[r] = fmaf(p0[r], C, mnC);
#pragma unroll
  for (int r = 0; r < 16; ++r) p1[r] = fmaf(p1[r], C, mnC);
#pragma unroll
  for (int r = 0; r < 16; ++r) p0[r] = __builtin_amdgcn_exp2f(p0[r]);
}
__device__ __forceinline__ void finishSM(f32x16& p0, f32x16& p1, float alpha, float& l_reg, bf16x8& pa0, bf16x8& pa1, bf16x8& pa2, bf16x8& pa3) {
#pragma unroll
  for (int r = 0; r < 16; ++r) p1[r] = __builtin_amdgcn_exp2f(p1[r]);
  float ps = 0;
#pragma unroll
  for (int r = 0; r < 16; ++r) ps += p0[r];
#pragma unroll
  for (int r = 0; r < 16; ++r) ps += p1[r];
  { auto rr = __builtin_amdgcn_permlane32_swap(__float_as_uint(ps), __float_as_uint(ps), false, false);
    ps = __uint_as_float(rr[0]) + __uint_as_float(rr[1]); }
  l_reg = l_reg * alpha + ps;
#define PK4(P, BASE, OUT) do { unsigned a0 = cvtpk(P[BASE + 0], P[BASE + 1]), a1 = cvtpk(P[BASE + 2], P[BASE + 3]);   \
    unsigned b0 = cvtpk(P[BASE + 4], P[BASE + 5]), b1 = cvtpk(P[BASE + 6], P[BASE + 7]);                              \
    auto r0 = __builtin_amdgcn_permlane32_swap(a0, b0, false, false); auto r1 = __builtin_amdgcn_permlane32_swap(a1, b1, false, false); \
    u32x4 w = {r0[0], r1[0], r0[1], r1[1]}; OUT = *reinterpret_cast<bf16x8*>(&w); } while (0)
  PK4(p0, 0, pa0); PK4(p0, 8, pa1); PK4(p1, 0, pa2); PK4(p1, 8, pa3);
#undef PK4
}
__device__ __forceinline__ void qkt(f32x16& p0, f32x16& p1, const bf16_t* Ks, const bf16x8* qr, int r32, int hi) {
  p0 = f32x16{}; p1 = f32x16{};
#pragma unroll
  for (int d0 = 0; d0 < 8; ++d0) { int cb = (d0 * 16 + hi * 8) * 2;
    bf16x8 b0 = *reinterpret_cast<const bf16x8*>((const char*)Ks + KSWZ(r32, cb));
    bf16x8 b1 = *reinterpret_cast<const bf16x8*>((const char*)Ks + KSWZ(32 + r32, cb));
    p0 = __builtin_amdgcn_mfma_f32_32x32x16_bf16(b0, qr[d0], p0, 0, 0, 0);
    p1 = __builtin_amdgcn_mfma_f32_32x32x16_bf16(b1, qr[d0], p1, 0, 0, 0); }
}
__device__ __forceinline__ int v_st(int k, int c) { const int kk = (k & ~0xC) | ((k & 4) << 1) | ((k & 8) >> 1); return ((kk >> 3) * 4 + (c >> 5)) * 512 + ((kk & 7) * 32 + (c & 31)) * 2; }
__device__ __forceinline__ int v_rd_base(int lane) { return ((lane & 3) << 3) | (((lane >> 2) & 3) << 6) | (((lane >> 4) & 1) << 5) | (((lane >> 5) & 1) << 8); }
constexpr int v_rd_off(int d0, int ks, int half) { return d0 * 512 + ks * 4096 + half * 2048; }
template <int OFF> __device__ __forceinline__ s16x4 tr_read(int vb) {
  s16x4 r; asm volatile("ds_read_b64_tr_b16 %0, %1 offset:%2" : "=&v"(r) : "v"(vb), "i"(OFF) : "memory"); return r;
}
template <int D0> __device__ __forceinline__ void pv_one(f32x16& od, int vb, bf16x8 pa0, bf16x8 pa1, bf16x8 pa2, bf16x8 pa3) {
  const s16x4 l0 = tr_read<v_rd_off(D0, 0, 0)>(vb), h0 = tr_read<v_rd_off(D0, 0, 1)>(vb), l1 = tr_read<v_rd_off(D0, 1, 0)>(vb), h1 = tr_read<v_rd_off(D0, 1, 1)>(vb);
  const s16x4 l2 = tr_read<v_rd_off(D0, 2, 0)>(vb), h2 = tr_read<v_rd_off(D0, 2, 1)>(vb), l3 = tr_read<v_rd_off(D0, 3, 0)>(vb), h3 = tr_read<v_rd_off(D0, 3, 1)>(vb);
  asm volatile("s_waitcnt lgkmcnt(0)" ::: "memory"); SBAR();
#define PK(L, H) (bf16x8){L[0], L[1], L[2], L[3], H[0], H[1], H[2], H[3]}
  od = __builtin_amdgcn_mfma_f32_32x32x16_bf16(pa0, PK(l0, h0), od, 0, 0, 0);
  od = __builtin_amdgcn_mfma_f32_32x32x16_bf16(pa1, PK(l1, h1), od, 0, 0, 0);
  od = __builtin_amdgcn_mfma_f32_32x32x16_bf16(pa2, PK(l2, h2), od, 0, 0, 0);
  od = __builtin_amdgcn_mfma_f32_32x32x16_bf16(pa3, PK(l3, h3), od, 0, 0, 0);
#undef PK
}
__device__ __forceinline__ void pv_d0(f32x16* o, int vb, bf16x8 pa0, bf16x8 pa1, bf16x8 pa2, bf16x8 pa3) {
  pv_one<0>(o[0], vb, pa0, pa1, pa2, pa3); pv_one<1>(o[1], vb, pa0, pa1, pa2, pa3); pv_one<2>(o[2], vb, pa0, pa1, pa2, pa3); pv_one<3>(o[3], vb, pa0, pa1, pa2, pa3);
}
__device__ __forceinline__ void attn_dense_body(const bf16_t* __restrict__ Qb, const bf16_t* __restrict__ Kh, const bf16_t* __restrict__ Vh,
                                                bf16_t* __restrict__ Ob, int seq, char* lds, const int tid, const int wid) {
  const int lane = tid & 63, r32 = lane & 31, hi = lane >> 5;
  bf16_t* V_lds = (bf16_t*)lds; bf16_t* K_lds = (bf16_t*)(lds + 2 * SHM_V);
  float* ws = (float*)(lds + 2 * SHM_V + 2 * SHM_K) + wid * 64; float* li_l = ws; float* al_l = ws + 32;
  float m_reg = -1e30f, l_reg = 0; f32x16 o[4] = {}; bf16x8 qr[8];
  const bf16_t* Qw = Qb + (long)(wid * QBLK + r32) * LDQ + hi * 8;
#pragma unroll
  for (int d0 = 0; d0 < 8; ++d0) qr[d0] = ld8(Qw + d0 * 16);
  const int sr = tid >> 4, sc = (tid & 15) * 8, vst0 = v_st(sr, sc), vst1 = v_st(32 + sr, sc);
  const int vb0 = (int)(uintptr_t)V_lds + v_rd_base(lane);
  struct { bf16x8 vs0, vs1, ks0, ks1; } sr_[2];
#define SLOAD(i, k0) do { sr_[i].vs0 = ld8(&Vh[(long)((k0) + sr) * LDK + sc]); sr_[i].vs1 = ld8(&Vh[(long)((k0) + 32 + sr) * LDK + sc]); \
    sr_[i].ks0 = ld8(&Kh[(long)((k0) + sr) * LDK + sc]); sr_[i].ks1 = ld8(&Kh[(long)((k0) + 32 + sr) * LDK + sc]); } while (0)
#define SWRITE(b, i) do { *(bf16x8*)((char*)V_lds + (b) * SHM_V + vst0) = sr_[i].vs0;          \
    *(bf16x8*)((char*)V_lds + (b) * SHM_V + vst1) = sr_[i].vs1; int kc = sc * 2;               \
    *(bf16x8*)((char*)K_lds + (b) * SHM_K + KSWZ(sr, kc)) = sr_[i].ks0;                       \
    *(bf16x8*)((char*)K_lds + (b) * SHM_K + KSWZ(32 + sr, kc)) = sr_[i].ks1; } while (0)
#define SWAIT() asm volatile("s_waitcnt vmcnt(4)" ::: "memory")
#define RESC(a) do { if (__any((a) < 1.f)) { if (hi == 0) al_l[r32] = (a); asm volatile("s_waitcnt lgkmcnt(0)" ::: "memory"); \
    _Pragma("unroll") for (int d = 0; d < 4; ++d) _Pragma("unroll") for (int r = 0; r < 16; ++r) o[d][r] *= al_l[crow(r, hi)]; } } while (0)
  f32x16 pA0, pA1, pB0, pB1; float mnA, mnB, alA, alB; bf16x8 pa0, pa1, pa2, pa3; const int NT = seq / KVBLK;
  constexpr int SE = 0, SO = 1;
  SLOAD(SE, 0); asm volatile("s_waitcnt vmcnt(0)" ::: "memory"); SWRITE(0, SE); __syncthreads();
  qkt(pA0, pA1, K_lds, qr, r32, hi); partialSM(pA0, pA1, m_reg, mnA, alA);
  SLOAD(SO, KVBLK); if (2 < NT) SLOAD(SE, 2 * KVBLK);
  SWAIT(); SWRITE(1, SO); __syncthreads();
  for (int j = 1; j + 1 < NT; j += 2) {
    SBAR(); qkt(pB0, pB1, (bf16_t*)((char*)K_lds + SHM_K), qr, r32, hi);
    finishSM(pA0, pA1, alA, l_reg, pa0, pa1, pa2, pa3); SBAR();
    SLOAD(SO, (j + 2) * KVBLK); SBAR();
    pv_d0(o, vb0, pa0, pa1, pa2, pa3); partialSM(pB0, pB1, m_reg, mnB, alB);
    __syncthreads(); SWAIT(); SWRITE(0, SE);
    RESC(alB); __syncthreads();
    SBAR(); qkt(pA0, pA1, K_lds, qr, r32, hi);
    finishSM(pB0, pB1, alB, l_reg, pa0, pa1, pa2, pa3); SBAR();
    if (j + 3 < NT) SLOAD(SE, (j + 3) * KVBLK); SBAR();
    pv_d0(o, vb0 + (int)SHM_V, pa0, pa1, pa2, pa3); partialSM(pA0, pA1, m_reg, mnA, alA);
    __syncthreads(); SWAIT(); SWRITE(1, SO);
    RESC(alA); __syncthreads();
  }
  SBAR(); qkt(pB0, pB1, (bf16_t*)((char*)K_lds + SHM_K), qr, r32, hi);
  finishSM(pA0, pA1, alA, l_reg, pa0, pa1, pa2, pa3); SBAR();
  pv_d0(o, vb0, pa0, pa1, pa2, pa3); partialSM(pB0, pB1, m_reg, mnB, alB);
  __syncthreads(); RESC(alB);
  finishSM(pB0, pB1, alB, l_reg, pa0, pa1, pa2, pa3); SBAR();
  pv_d0(o, vb0 + (int)SHM_V, pa0, pa1, pa2, pa3);
  if (hi == 0) li_l[r32] = l_reg; asm volatile("s_waitcnt lgkmcnt(0)" ::: "memory");
  float rli[16];
#pragma unroll
  for (int r = 0; r < 16; ++r) rli[r] = __builtin_amdgcn_rcpf(li_l[crow(r, hi)]);
  bf16_t* Ow = Ob + (long)(wid * QBLK) * LDO;
#pragma unroll
  for (int r = 0; r < 16; ++r) { int orow = crow(r, hi);
#pragma unroll
    for (int d0 = 0; d0 < 4; ++d0) Ow[(long)orow * LDO + d0 * 32 + r32] = (bf16_t)(pk2(o[d0][r] * rli[r], 0.f) & 0xffffu); }
#undef SLOAD
#undef SWRITE
#undef SWAIT
#undef RESC
}
#undef KSWZ
#undef SBAR
}

__device__ __forceinline__ unsigned f2ord(float f) { const unsigned u = __float_as_uint(f); return u ^ ((unsigned)((int)u >> 31) | 0x80000000u); }
__device__ __forceinline__ float ord2f(unsigned k) { const unsigned u = (k & 0x80000000u) ? (k & 0x7fffffffu) : ~k; return __uint_as_float(u); }
template <int CTRL> __device__ __forceinline__ unsigned dppu(unsigned v) { return (unsigned)__builtin_amdgcn_update_dpp(0, (int)v, CTRL, 0xF, 0xF, false); }
template <int CTRL> __device__ __forceinline__ float dppf(float v) { return __int_as_float(__builtin_amdgcn_update_dpp(0, __float_as_int(v), CTRL, 0xF, 0xF, false)); }
constexpr int DPP_X1 = 0xB1, DPP_X2 = 0x4E, DPP_HMIR = 0x141, DPP_MIR = 0x140;
__device__ __forceinline__ unsigned umax_(unsigned a, unsigned b) { return a > b ? a : b; }
__device__ __forceinline__ unsigned umin_(unsigned a, unsigned b) { return a < b ? a : b; }
template <int N> __device__ __forceinline__ void bitonic_sort_desc(unsigned (&k)[N]) {
#pragma unroll
    for (int size = 2; size <= N; size <<= 1) {
#pragma unroll
        for (int stride = size >> 1; stride > 0; stride >>= 1) {
#pragma unroll
            for (int i = 0; i < N; ++i) { const int j = i ^ stride;
                if (j > i) { const bool desc = ((i & size) == 0) || (size == N); const unsigned a = k[i], b = k[j], mx = umax_(a, b), mn = umin_(a, b); k[i] = desc ? mx : mn; k[j] = desc ? mn : mx; } }
        }
    }
}
__device__ __forceinline__ void sort16_desc(unsigned (&k)[16]) {
    constexpr int P[63][2] = {{0, 1}, {2, 3}, {0, 2}, {1, 3}, {1, 2}, {4, 5}, {6, 7}, {4, 6}, {5, 7}, {5, 6}, {0, 4}, {2, 6}, {2, 4}, {1, 5}, {3, 7}, {3, 5}, {1, 2}, {3, 4}, {5, 6}, {8, 9}, {10, 11}, {8, 10}, {9, 11}, {9, 10}, {12, 13}, {14, 15}, {12, 14}, {13, 15}, {13, 14}, {8, 12}, {10, 14}, {10, 12}, {9, 13}, {11, 15}, {11, 13}, {9, 10}, {11, 12}, {13, 14}, {0, 8}, {4, 12}, {4, 8}, {2, 10}, {6, 14}, {6, 10}, {2, 4}, {6, 8}, {10, 12}, {1, 9}, {5, 13}, {5, 9}, {3, 11}, {7, 15}, {7, 11}, {3, 5}, {7, 9}, {11, 13}, {1, 2}, {3, 4}, {5, 6}, {7, 8}, {9, 10}, {11, 12}, {13, 14}};
#pragma unroll
    for (int c = 0; c < 63; ++c) { const unsigned a = k[P[c][0]], b = k[P[c][1]]; k[P[c][0]] = umax_(a, b); k[P[c][1]] = umin_(a, b); }
}
typedef short s16x2_t __attribute__((ext_vector_type(2)));
__device__ __forceinline__ unsigned h2ord2(unsigned w) { const s16x2_t m = __builtin_bit_cast(s16x2_t, w) >> 15; return w ^ (__builtin_bit_cast(unsigned, m) | 0x80008000u); }
__device__ __forceinline__ float okey2f(unsigned k) { unsigned h = k >> 16; h ^= ((int)k < 0) ? 0x8000u : 0xFFFFu; return (float)__builtin_bit_cast(_Float16, (unsigned short)h); }
template <int N> __device__ __forceinline__ void bitonic_merge_desc(unsigned (&k)[N]) {
#pragma unroll
    for (int stride = N >> 1; stride > 0; stride >>= 1) {
#pragma unroll
        for (int i = 0; i < N; ++i) { const int j = i ^ stride; if (j > i) { const unsigned a = k[i], b = k[j]; k[i] = umax_(a, b); k[j] = umin_(a, b); } }
    }
}
__device__ __forceinline__ float dot2bf(unsigned w, unsigned x, float acc) { return __builtin_amdgcn_fdot2_f32_bf16(__builtin_bit_cast(bf16x2_t, w), __builtin_bit_cast(bf16x2_t, x), acc, false); }
__device__ __forceinline__ float wave_sum_dpp(float v) {
    v += dppf<DPP_X1>(v); v += dppf<DPP_X2>(v); v += dppf<DPP_HMIR>(v); v += dppf<DPP_MIR>(v);
    return (__int_as_float(__builtin_amdgcn_readlane(__float_as_int(v), 0)) + __int_as_float(__builtin_amdgcn_readlane(__float_as_int(v), 16))) +
           (__int_as_float(__builtin_amdgcn_readlane(__float_as_int(v), 32)) + __int_as_float(__builtin_amdgcn_readlane(__float_as_int(v), 48)));
}

__device__ __forceinline__ int win_src_col(int r) {
    const int tile = r >> 8, w = r & 255;
    if (tile < 4) return OFF_Q + r;
    if (tile == 4) return OFF_K + w;
    if (tile == 5) return OFF_V + w;
    if (tile < 14) { const int j = tile - 6; return (w < 128) ? (OFF_CH + j * 128 + w) : (OFF_CC + j * 128 + (w - 128)); }
    if (tile < 18) return OFF_CB + (r - 14 * 256);
    if (tile < 26) return OFF_GA + (r - 18 * 256);
    return OFF_GC + (r - 26 * 256);
}
__device__ __forceinline__ void transpose_item(const float* __restrict__ W, int ldw, int k0, int nsrc0, bf16_t* WT, int ldd, int drow0, int dcol0, const float* g, LAS float* scr, int lane) {
    { float v[32]; const float* wp = W + (size_t)(k0 + (lane >> 5)) * ldw + nsrc0 + (lane & 31);
#pragma unroll
      for (int i = 0; i < 32; ++i) v[i] = wp[(size_t)(2 * i) * ldw];
      if (g) {
#pragma unroll
          for (int i = 0; i < 32; ++i) v[i] *= g[k0 + 2 * i + (lane >> 5)]; }
#pragma unroll
      for (int i = 0; i < 32; ++i) scr[(2 * i + (lane >> 5)) * 33 + (lane & 31)] = v[i]; }
    LDS_WAIT();
    const int c = lane & 7;
#pragma unroll
    for (int j = 0; j < 4; ++j) { const int n = (lane >> 3) + 8 * j; const LAS float* s = scr + (8 * c) * 33 + n;
        u32x4 o; o.x = pk2(s[0 * 33], s[1 * 33]); o.y = pk2(s[2 * 33], s[3 * 33]); o.z = pk2(s[4 * 33], s[5 * 33]); o.w = pk2(s[6 * 33], s[7 * 33]);
        *(u32x4*)(WT + (size_t)(drow0 + n) * ldd + dcol0 + 8 * c) = o; }
    LDS_WAIT();
}


__device__ __forceinline__ unsigned q8(float v) { return (unsigned)__float2int_rn(fminf(fmaxf(v, -127.0f), 127.0f)) & 0xffu; }
__device__ __forceinline__ unsigned q8x4(float a, float b, float c, float d) { return q8(a) | (q8(b) << 8) | (q8(c) << 16) | (q8(d) << 24); }
__device__ __forceinline__ void colmax_item(const float* __restrict__ W, int ldw, int k0, int nsrc0, const float* g, unsigned* cmax, int drow0, int lane) {
    float m = 0.f;
    { float v[32]; const float* wp = W + (size_t)(k0 + (lane >> 5)) * ldw + nsrc0 + (lane & 31);
#pragma unroll
      for (int i = 0; i < 32; ++i) v[i] = wp[(size_t)(2 * i) * ldw];
#pragma unroll
      for (int i = 0; i < 32; ++i) m = fmaxf(m, fabsf(v[i] * g[k0 + 2 * i + (lane >> 5)])); }
    m = fmaxf(m, __shfl_xor(m, 32));
    if (lane < 32) atomicMax(cmax + drow0 + lane, __float_as_uint(m));
}
__device__ __forceinline__ void quant_transpose_item(const float* __restrict__ W, int ldw, int k0, int nsrc0, unsigned char* WT, int ldd_b, int drow0, int dcol0, const float* g, unsigned* cmax, LAS float* scr, int lane) {
    { float v[32]; const float* wp = W + (size_t)(k0 + (lane >> 5)) * ldw + nsrc0 + (lane & 31);
#pragma unroll
      for (int i = 0; i < 32; ++i) v[i] = wp[(size_t)(2 * i) * ldw];
#pragma unroll
      for (int i = 0; i < 32; ++i) scr[(2 * i + (lane >> 5)) * 33 + (lane & 31)] = v[i] * g[k0 + 2 * i + (lane >> 5)]; }
    LDS_WAIT();
#pragma unroll
    for (int j = 0; j < 2; ++j) { const int p = lane + 64 * j, n = p >> 2, c4 = p & 3;
        const float cm = __uint_as_float(__hip_atomic_load(cmax + drow0 + n, __ATOMIC_RELAXED, __HIP_MEMORY_SCOPE_AGENT)); const float sc = cm > 0.f ? 127.0f / cm : 0.f;
        const LAS float* sp = scr + (16 * c4) * 33 + n; u32x4 o;
#pragma unroll
        for (int q = 0; q < 4; ++q) o[q] = q8x4(sp[(4 * q) * 33] * sc, sp[(4 * q + 1) * 33] * sc, sp[(4 * q + 2) * 33] * sc, sp[(4 * q + 3) * 33] * sc);
        *(u32x4*)(WT + (size_t)(drow0 + n) * ldd_b + dcol0 + 16 * c4) = o; }
    LDS_WAIT();
}

#define XB_TMO      128
#define XB_XCNT(j)  (256  + 64 * (j))
#define XB_XSUB(j)  (1280 + 64 * (j))
#define XB_XGEN(j)  (2304 + 64 * (j))
#define XB_TOP      3328
#define XB_TOPGEN   3392
#define XCD_BAR_WORDS 3456
#define XB_GMASK(g) (8 + (g))
#define XB_LSUB(j)  (3456 + 32 * (j))
#define XB_SPIN_CAP (1u << 18)
__device__ __forceinline__ unsigned xb_ld(unsigned* p)              { return __hip_atomic_load(p, __ATOMIC_RELAXED, __HIP_MEMORY_SCOPE_AGENT); }
__device__ __forceinline__ unsigned xb_add(unsigned* p, unsigned v) { return __hip_atomic_fetch_add(p, v, __ATOMIC_RELAXED, __HIP_MEMORY_SCOPE_AGENT); }
__device__ __forceinline__ unsigned xb_xcc_id() { return (unsigned)__builtin_amdgcn_s_getreg((3 << 11) | 20) & 0xFu; }
#define XB_SPIN(cond, bar) do { unsigned _sp = 0; while (cond) { __builtin_amdgcn_s_sleep(1); \
    if ((++_sp & 255u) == 0u) { if (xb_ld(&(bar)[XB_TMO])) break; if (_sp > XB_SPIN_CAP) { atomicAdd(&(bar)[XB_TMO], 1u); break; } } } } while (0)
__device__ __forceinline__ void xcd_barrier_complete(unsigned* bar, unsigned x, unsigned& nloc, unsigned& nx) {
    const unsigned G = gridDim.x;
    unsigned sum, cnt, mine, sp = 0u;
    for (;;) {
        sum = 0u; cnt = 0u; mine = 0u;
#pragma unroll
        for (unsigned j = 0; j < 16; ++j) { const unsigned c = xb_ld(&bar[XB_XCNT(j)]); sum += c; cnt += (c > 0u) ? 1u : 0u; mine = (j == x) ? c : mine; }
        if (sum == G) break;
        __builtin_amdgcn_s_sleep(1);
        if ((++sp & 255u) == 0u) { if (xb_ld(&bar[XB_TMO])) break; if (sp > XB_SPIN_CAP) { atomicAdd(&bar[XB_TMO], 1u); break; } }
    }
    nloc = mine > 0u ? mine : 1u; nx = cnt > 0u ? cnt : 1u;
}
__device__ __forceinline__ void xcd_barrier_leader(unsigned* bar, volatile LAS unsigned* st) {
    {
        __builtin_amdgcn_s_waitcnt(0);
        const unsigned x = xb_xcc_id();
        unsigned nloc = st[0], nx = st[1];
        if (nloc == 0u) { xcd_barrier_complete(bar, x, nloc, nx); st[0] = nloc; st[1] = nx; }
        const unsigned old = xb_add(&bar[XB_XSUB(x)], 1u);
        const unsigned gen = old / nloc;
        if (old + 1u == (gen + 1u) * nloc) {
            __builtin_amdgcn_fence(__ATOMIC_RELEASE, "agent");
            asm volatile("s_waitcnt vmcnt(0)" ::: "memory");
            const unsigned og = xb_add(&bar[XB_TOP], 1u);
            const unsigned tg = og / nx;
            if (og + 1u != (tg + 1u) * nx) XB_SPIN(xb_ld(&bar[XB_TOP]) < (tg + 1u) * nx, bar);
            xb_add(&bar[XB_XGEN(x)], 1u);
            __builtin_amdgcn_fence(__ATOMIC_ACQUIRE, "agent");
            asm volatile("s_waitcnt vmcnt(0)" ::: "memory");
        } else {
            XB_SPIN(xb_ld(&bar[XB_XGEN(x)]) == gen, bar);
            __builtin_amdgcn_fence(__ATOMIC_ACQUIRE, "agent");
            asm volatile("s_waitcnt vmcnt(0)" ::: "memory");
        }
    }
}
__device__ __forceinline__ void xcd_barrier(unsigned* bar, volatile LAS unsigned* st, const bool leader) {
    asm volatile("s_waitcnt vmcnt(0)" ::: "memory");
    __syncthreads();
    if (leader) xcd_barrier_leader(bar, st);
    __syncthreads();
}
__device__ __forceinline__ void xcd_local_seam(unsigned* bar, volatile LAS unsigned* st, const bool leader, const int k) {
    asm volatile("s_waitcnt vmcnt(0)" ::: "memory");
    __syncthreads();
    if (leader) {
        __builtin_amdgcn_s_waitcnt(0);
        unsigned mode = ((gridDim.x & 7u) == 0u && st[0] != 0u) ? 1u : 2u;
#pragma unroll
        for (unsigned g = 0; g < 8; ++g) { const unsigned m = xb_ld(&bar[XB_GMASK(g)]); if (m == 0u || (m & (m - 1u)) != 0u) mode = 2u; }
        if (mode == 1u) {
            const unsigned x = xb_xcc_id(), nloc = st[0];
            (void)xb_add(&bar[XB_LSUB(x) + k], 1u);
            XB_SPIN(xb_ld(&bar[XB_LSUB(x) + k]) < nloc, bar);
            __builtin_amdgcn_fence(__ATOMIC_ACQUIRE, "agent");
            asm volatile("s_waitcnt vmcnt(0)" ::: "memory");
        } else xcd_barrier_leader(bar, st);
    }
    __syncthreads();
}

struct Args { const float* in[18]; float* out; unsigned char* ws; int ph_lo, ph_hi; };
enum { IN_X = 0, IN_P, IN_GMIX, IN_WIN, IN_GQ, IN_GK, IN_CONVW, IN_WAO, IN_WCO, IN_WOUT, IN_GFFN, IN_WPQ, IN_KEYS, IN_U, IN_V, IN_GPLE, IN_WPLE, IN_WPG };

#define CAS __attribute__((address_space(4)))
typedef const float* cfptr_t; typedef float* fptr_t; typedef unsigned char* ucptr_t;
#define KARG_PTR(i) (*(const CAS cfptr_t*)(ka + 8 * (i)))
#define PH_LOCALS \
    const CAS unsigned char* ka = (const CAS unsigned char*)__builtin_amdgcn_kernarg_segment_ptr(); asm volatile("" : "+s"(ka)); \
    const int wave = wave0; \
    int lane = (int)__builtin_amdgcn_mbcnt_hi(~0u, __builtin_amdgcn_mbcnt_lo(~0u, 0u)); asm volatile("" : "+v"(lane)); \
    const int tid = wave * 64 + lane; \
    int G = gridDim.x, bx = blockIdx.x; asm volatile("" : "+s"(G), "+s"(bx)); \
    const int vcu = (G % 8 == 0) ? (bx % 8) * (G / 8) + bx / 8 : bx; \
    const int gw = vcu * NW + wave, NGW = G * NW; const int gt = vcu * (NW * 64) + tid, NGT = G * NW * 64; \
    unsigned char* ws = *(const CAS ucptr_t*)(ka + 152); float* out = *(const CAS fptr_t*)(ka + 144); \
    LAS unsigned char* L = (LAS unsigned char*)lds; \
    (void)lane; (void)wave; (void)vcu; (void)gw; (void)NGW; (void)gt; (void)NGT; (void)ws; (void)out; (void)L;

constexpr int LDS_BARST = 160768;

__global__ void __launch_bounds__(NW * 64, 2) mega_fwd(Args args) {
    extern __shared__ __attribute__((aligned(16))) unsigned char lds[];
    const int wave0 = __builtin_amdgcn_readfirstlane((int)threadIdx.x >> 6);
    const int lo = args.ph_lo, hi = args.ph_hi;
    {
        if (threadIdx.x == 0) { volatile LAS unsigned* st = (volatile LAS unsigned*)((LAS unsigned char*)lds + LDS_BARST); st[0] = 0u; st[1] = 0u;
            unsigned* bar = (unsigned*)(args.ws + WS_CTL); const unsigned xc_ = xb_xcc_id(); (void)xb_add(&bar[XB_XCNT(xc_)], 1u);
            (void)__hip_atomic_fetch_or(&bar[XB_GMASK(blockIdx.x & 7u)], 1u << xc_, __ATOMIC_RELAXED, __HIP_MEMORY_SCOPE_AGENT); }
        __syncthreads();
    }
#ifdef ONLY_PHASE
#define IN(k) ((k) == ONLY_PHASE && lo <= (k) && (k) < hi)
#else
#define IN(k) (lo <= (k) && (k) < hi)
#endif
#define SEAM(k) do { if (IN(k) && IN((k) + 1)) { \
        const CAS unsigned char* ka_ = (const CAS unsigned char*)__builtin_amdgcn_kernarg_segment_ptr(); asm volatile("" : "+s"(ka_)); \
        const int lane_ = (int)__builtin_amdgcn_mbcnt_hi(~0u, __builtin_amdgcn_mbcnt_lo(~0u, 0u)); \
        xcd_barrier((unsigned*)(*(const CAS ucptr_t*)(ka_ + 152) + WS_CTL), (volatile LAS unsigned*)((LAS unsigned char*)lds + LDS_BARST), wave0 == 0 && lane_ == 0); } } while (0)
#define LSEAM(k, idx) do { if (IN(k) && IN((k) + 1)) { \
        const CAS unsigned char* ka_ = (const CAS unsigned char*)__builtin_amdgcn_kernarg_segment_ptr(); asm volatile("" : "+s"(ka_)); \
        const int lane_ = (int)__builtin_amdgcn_mbcnt_hi(~0u, __builtin_amdgcn_mbcnt_lo(~0u, 0u)); \
        xcd_local_seam((unsigned*)(*(const CAS ucptr_t*)(ka_ + 152) + WS_CTL), (volatile LAS unsigned*)((LAS unsigned char*)lds + LDS_BARST), wave0 == 0 && lane_ == 0, (idx)); } } while (0)
#define WSP(T_, off) ((T_*)(ws + (off)))

    if (IN(0)) {
        PH_LOCALS
        const float* x = KARG_PTR(IN_X);
        float* XS1 = WSP(float, WS_XS1); bf16_t* KEYBD = WSP(bf16_t, WS_KEYBD); bf16_t* WPLET = WSP(bf16_t, WS_WPLET); bf16_t* PB = WSP(bf16_t, WS_PB);
        unsigned char* WGQ = WSP(unsigned char, WS_WGQ); unsigned char* WINQ = WSP(unsigned char, WS_WINQ); unsigned* CMAX = WSP(unsigned, WS_CMAX);
        bf16_t* W3AT = WSP(bf16_t, WS_W3AT); bf16_t* WOUTT = WSP(bf16_t, WS_WOUTT); bf16_t* WQP = WSP(bf16_t, WS_WQP);
        unsigned char* UB = WSP(unsigned char, WS_UB); unsigned char* VB = WSP(unsigned char, WS_VB); unsigned char* XQ = WSP(unsigned char, WS_XB);
        LAS float* scr = (LAS float*)(L + wave * 16384);
        constexpr int I_IN = 32 * 272, I_G = 32 * 64, I_AO = 16 * 64, I_CO = 16 * 64, I_OUT = 32 * 64, I_PLE = 4 * 64;
        for (int it = gw; it < I_IN + I_G; it += NGW) {
            if (it < I_IN) { const int kb = it / 272, nb = it % 272; colmax_item(KARG_PTR(IN_WIN), W_IN, kb * 64, win_src_col(nb * 32), KARG_PTR(IN_GMIX), CMAX, nb * 32, lane); }
            else { const int r = it - I_IN, kb = r / 64, nb = r % 64; colmax_item(KARG_PTR(IN_WPG), DM, kb * 64, nb * 32, KARG_PTR(IN_GPLE), CMAX + W_IN, nb * 32, lane); }
        }
        { const float* src = KARG_PTR(IN_WPQ); const float* gf = KARG_PTR(IN_GFFN);
          for (int i = gt; i < DM * DM / 8; i += NGT) { const float g = gf[i >> 8]; const f32x4 a = *(const f32x4*)(src + (size_t)i * 8), b = *(const f32x4*)(src + (size_t)i * 8 + 4);
              u32x4 w; w.x = pk2(a[0] * g, a[1] * g); w.y = pk2(a[2] * g, a[3] * g); w.z = pk2(b[0] * g, b[1] * g); w.w = pk2(b[2] * g, b[3] * g); *(u32x4*)(WQP + (size_t)i * 8) = w; } }
        { const float* src = KARG_PTR(IN_KEYS);
          for (int i = gt; i < 2048 * 256 / 8; i += NGT) { const int row = i >> 5, c8 = (i & 31) * 8, hp = row >> 7; u32x4 w = {0u, 0u, 0u, 0u};
              if ((c8 >> 7) == (hp & 1)) { const float* s = src + (size_t)row * 128 + (c8 & 127); const f32x4 a = *(const f32x4*)s, b = *(const f32x4*)(s + 4);
                  w.x = pk2(a[0], a[1]); w.y = pk2(a[2], a[3]); w.z = pk2(b[0], b[1]); w.w = pk2(b[2], b[3]); }
              *(u32x4*)(KEYBD + (size_t)i * 8) = w; } }
        { const float* su = KARG_PTR(IN_U); const float* gf = KARG_PTR(IN_GFFN); float* SU = WSP(float, WS_SU); f32x4 g4[8];
#pragma unroll
          for (int j = 0; j < 8; ++j) g4[j] = ((const f32x4*)gf)[8 * lane + j];
          for (int e = gw; e < 16384; e += NGW) { const f32x4* ur = (const f32x4*)(su + (size_t)e * DM) + 8 * lane; f32x4 v[8]; float am = 0.f, ss = 0.f;
#pragma unroll
              for (int j = 0; j < 8; ++j) { v[j] = ur[j] * g4[j]; am = fmaxf(fmaxf(am, fmaxf(fabsf(v[j][0]), fabsf(v[j][1]))), fmaxf(fabsf(v[j][2]), fabsf(v[j][3])));
                  ss += (v[j][0] * v[j][0] + v[j][1] * v[j][1]) + (v[j][2] * v[j][2] + v[j][3] * v[j][3]); }
#pragma unroll
              for (int o = 1; o < 64; o <<= 1) { am = fmaxf(am, __shfl_xor(am, o)); ss += __shfl_xor(ss, o); }
              const float step = fminf(am * 0.125f, 0.3352f * sqrtf(ss * (1.0f / DM)));
              if (lane == 0) SU[e] = step;
              const float inv = step > 0.f ? 1.0f / step : 0.f; u32x4 w;
#pragma unroll
              for (int q = 0; q < 4; ++q) { unsigned r = 0u;
#pragma unroll
                  for (int i = 0; i < 8; ++i) { const float f = floorf(v[2 * q + (i >> 2)][i & 3] * inv); const int n = (int)fminf(fmaxf(f, -8.0f), 7.0f); r |= ((unsigned)n & 15u) << (4 * ((i < 4) ? 2 * i : 2 * (i - 4) + 1)); }
                  w[q] = r; }
              *(u32x4*)(UB + (size_t)(lane >> 3) * (16384u * 128u) + (size_t)e * 128u + (lane & 7) * 16) = w; } }
        { const float* sv = KARG_PTR(IN_V); float* SV = WSP(float, WS_SV);
          for (int e = gw; e < 16384; e += NGW) { const f32x4* vr = (const f32x4*)(sv + (size_t)e * DM) + 8 * lane; f32x4 v[8]; float am = 0.f, ss = 0.f;
#pragma unroll
              for (int j = 0; j < 8; ++j) { v[j] = vr[j]; am = fmaxf(fmaxf(am, fmaxf(fabsf(v[j][0]), fabsf(v[j][1]))), fmaxf(fabsf(v[j][2]), fabsf(v[j][3])));
                  ss += (v[j][0] * v[j][0] + v[j][1] * v[j][1]) + (v[j][2] * v[j][2] + v[j][3] * v[j][3]); }
#pragma unroll
              for (int o = 1; o < 64; o <<= 1) { am = fmaxf(am, __shfl_xor(am, o)); ss += __shfl_xor(ss, o); }
              const float step = fminf(am * 0.125f, 0.3352f * sqrtf(ss * (1.0f / DM)));
              if (lane == 0) SV[e] = step;
              const float inv = step > 0.f ? 1.0f / step : 0.f; u32x4 w;
#pragma unroll
              for (int q = 0; q < 4; ++q) { unsigned r = 0u;
#pragma unroll
                  for (int i = 0; i < 8; ++i) { const float f = floorf(v[i][q] * inv); const int n = (int)fminf(fmaxf(f, -8.0f), 7.0f); r |= ((unsigned)n & 15u) << (4 * i); }
                  w[q] = r; }
              { const int k_ = lane & 7, src0 = (lane & ~7) + 4 * (k_ & 1); u32x4 o;
#pragma unroll
                for (int j = 0; j < 4; ++j) { const unsigned a0 = __shfl(w[0], src0 + j), a1 = __shfl(w[1], src0 + j), a2 = __shfl(w[2], src0 + j), a3 = __shfl(w[3], src0 + j);
                    o[j] = (k_ < 4) ? ((k_ < 2) ? a0 : a1) : ((k_ < 6) ? a2 : a3); }
                *(u32x4*)(VB + (size_t)(lane >> 3) * (16384u * 128u) + (size_t)e * 128u + k_ * 16) = o; } } }
        for (int m = gw; m < T; m += NGW) { const f32x4* xr = (const f32x4*)(x + (size_t)m * DM) + lane; f32x4 v[8]; float s = 0.f, am = 0.f;
#pragma unroll
            for (int j = 0; j < 8; ++j) { v[j] = xr[64 * j]; s += (v[j][0] * v[j][0] + v[j][1] * v[j][1]) + (v[j][2] * v[j][2] + v[j][3] * v[j][3]);
                am = fmaxf(fmaxf(am, fmaxf(fabsf(v[j][0]), fabsf(v[j][1]))), fmaxf(fabsf(v[j][2]), fabsf(v[j][3]))); }
            s = wave_sum(s);
#pragma unroll
            for (int o = 1; o < 64; o <<= 1) am = fmaxf(am, __shfl_xor(am, o));
            if (lane == 0) XS1[m] = (1.0f / sqrtf(s * (1.0f / DM) + EPS)) * am * (1.0f / 127.0f);
            const float sc = am > 0.f ? 127.0f / am : 0.f;
            unsigned* o = (unsigned*)(XQ + (size_t)m * DM) + lane;
#pragma unroll
            for (int j = 0; j < 8; ++j) o[64 * j] = q8x4(v[j][0] * sc, v[j][1] * sc, v[j][2] * sc, v[j][3] * sc); }
        xcd_barrier((unsigned*)(ws + WS_CTL), (volatile LAS unsigned*)(L + LDS_BARST), wave == 0 && lane == 0);
        for (int it = gw; it < I_IN + I_G; it += NGW) {
            if (it < I_IN) { const int kb = it / 272, nb = it % 272; quant_transpose_item(KARG_PTR(IN_WIN), W_IN, kb * 64, win_src_col(nb * 32), WINQ, DM, nb * 32, kb * 64, KARG_PTR(IN_GMIX), CMAX, scr, lane); }
            else { const int r = it - I_IN, kb = r / 64, nb = r % 64; quant_transpose_item(KARG_PTR(IN_WPG), DM, kb * 64, nb * 32, WGQ, DM, nb * 32, kb * 64, KARG_PTR(IN_GPLE), CMAX + W_IN, scr, lane); }
        }
    }
    SEAM(0);

    if (IN(1)) {
        PH_LOCALS
        unsigned char* XQ = WSP(unsigned char, WS_XB); unsigned char* WINQ = WSP(unsigned char, WS_WINQ); bf16_t* KEYBD = WSP(bf16_t, WS_KEYBD); bf16_t* WQP = WSP(bf16_t, WS_WQP); bf16_t* WQKT = WSP(bf16_t, WS_WQKT);
        bf16_t* QB = WSP(bf16_t, WS_Q); bf16_t* KVB = WSP(bf16_t, WS_KV); bf16_t* PROD = WSP(bf16_t, WS_PROD); bf16_t* CBB = WSP(bf16_t, WS_CB); unsigned char* SGA = WSP(unsigned char, WS_SGA); unsigned char* SGC = WSP(unsigned char, WS_SGC);
        float* XS1 = WSP(float, WS_XS1); const float* CMAXF = WSP(float, WS_CMAX);
        { pg8::Gemm g{XQ, WINQ, DM, DM, DM, 0}; pg8::StaticOrder S; S.init(T, W_IN, G, bx);
          pg8::Epi1 E{QB, KVB, PROD, CBB, SGA, SGC, XS1, CMAXF};
          pg8::gemm_phase<pg8::Epi1, pg8::StaticOrder, true>(L, g, S, E, tid, wave); }
        { pg8::Gemm g{KEYBD, WQP, 512, 512, 2 * DM, 512}; pg8::StaticOrder S; S.init(2048, 2048, G, (bx >= G - 64) ? bx - (G - 64) : (1 << 24));
          pg8::EpiBf16 E{WQKT, DM};
          pg8::gemm_phase<pg8::EpiBf16, pg8::StaticOrder>(L, g, S, E, tid, wave); }
        { const int nh = G / 2, h0 = G - nh;
          if (bx >= h0) { constexpr int I_AO = 16 * 64, I_CO = 16 * 64, I_OUT = 32 * 64, I_PLE = 4 * 64;
              bf16_t* W3AT = WSP(bf16_t, WS_W3AT); bf16_t* WOUTT = WSP(bf16_t, WS_WOUTT); bf16_t* WPLET = WSP(bf16_t, WS_WPLET);
              LAS float* scr = (LAS float*)(L + 16384 + wave * 16384);
              for (int it = (bx - h0) * NW + wave; it < I_AO + I_CO + I_OUT + I_PLE; it += nh * NW) {
                  int r = it;
                  if (r < I_AO) { const int kb = r / 64, nb = r % 64; transpose_item(KARG_PTR(IN_WAO), DM, kb * 64, nb * 32, W3AT, DM, nb * 32, kb * 64, nullptr, scr, lane); continue; } r -= I_AO;
                  if (r < I_CO) { const int kb = r / 64, nb = r % 64; transpose_item(KARG_PTR(IN_WCO), DM, kb * 64, nb * 32, W3AT, DM, nb * 32, 1024 + kb * 64, nullptr, scr, lane); continue; } r -= I_CO;
                  if (r < I_OUT) { const int kb = r / 64, nb = r % 64; transpose_item(KARG_PTR(IN_WOUT), DM, kb * 64, nb * 32, WOUTT, DM, nb * 32, kb * 64, nullptr, scr, lane); continue; } r -= I_OUT;
                  { const int kb = r / 64, nb = r % 64; transpose_item(KARG_PTR(IN_WPLE), DM, kb * 64, nb * 32, WPLET, 256, nb * 32, kb * 64, nullptr, scr, lane); }
              }
              { const float* src = KARG_PTR(IN_P); bf16_t* PB = WSP(bf16_t, WS_PB);
                for (int i = (bx - h0) * (NW * 64) + tid; i < T * 256 / 8; i += nh * (NW * 64)) { const f32x4 a = *(const f32x4*)(src + (size_t)i * 8), b = *(const f32x4*)(src + (size_t)i * 8 + 4);
                    u32x4 w; w.x = pk2(a[0], a[1]); w.y = pk2(a[2], a[3]); w.z = pk2(b[0], b[1]); w.w = pk2(b[2], b[3]); *(u32x4*)(PB + (size_t)i * 8) = w; } }
          } }
        { LAS f32x2* LT = (LAS f32x2*)L;
#pragma unroll
          for (int k = 0; k < 4; ++k) { const int idx = tid + 512 * k, pos = idx >> 5, f = idx & 31; const float inv = powf(10000.0f, -(float)(2 * f) / 64.0f);
              float sn, cs; sincosf((float)pos * inv, &sn, &cs); LT[idx] = (f32x2){cs, sn}; }
          __syncthreads(); }
    }
    SEAM(1);

    if (IN(2)) {
        PH_LOCALS
        bf16_t* QB = WSP(bf16_t, WS_Q); bf16_t* KVB = WSP(bf16_t, WS_KV); bf16_t* PROD = WSP(bf16_t, WS_PROD); bf16_t* CBB = WSP(bf16_t, WS_CB); bf16_t* AC = WSP(bf16_t, WS_XB);
        const float* gq = KARG_PTR(IN_GQ); const float* gk = KARG_PTR(IN_GK);
        { const LAS f32x2* LT = (const LAS f32x2*)L; const int l7 = lane & 7, fb = 16 * (lane & 1); const bool axc = (l7 >> 2) != 0, neg = (lane & 3) < 2;
          float gqv[16], gkv[16];
#pragma unroll
          for (int e = 0; e < 16; ++e) { gqv[e] = gq[16 * l7 + e]; gkv[e] = gk[16 * l7 + e]; }
#define QK_ROW(A_, B_, GV, SQ) do { float xx[16]; \
              xx[0] = bflo(A_.x); xx[1] = bfhi(A_.x); xx[2] = bflo(A_.y); xx[3] = bfhi(A_.y); xx[4] = bflo(A_.z); xx[5] = bfhi(A_.z); xx[6] = bflo(A_.w); xx[7] = bfhi(A_.w); \
              xx[8] = bflo(B_.x); xx[9] = bfhi(B_.x); xx[10] = bflo(B_.y); xx[11] = bfhi(B_.y); xx[12] = bflo(B_.z); xx[13] = bfhi(B_.z); xx[14] = bflo(B_.w); xx[15] = bfhi(B_.w); \
              float ss_ = 0.f; _Pragma("unroll") for (int e = 0; e < 16; ++e) ss_ += xx[e] * xx[e]; \
              ss_ += dppf<DPP_X1>(ss_); ss_ += dppf<DPP_X2>(ss_); ss_ += dppf<DPP_HMIR>(ss_); \
              const float r_ = 1.0f / sqrtf(ss_ * (1.0f / 128.0f) + EPS); \
              const LAS f32x2* lt_ = LT + (axc ? ((SQ) & 63) : ((SQ) >> 6)) * 32 + fb; float oo[16]; \
              _Pragma("unroll") for (int e = 0; e < 16; ++e) { const float y_ = xx[e] * r_ * GV[e]; const float p_ = dppf<DPP_X2>(y_); const f32x2 cs_ = lt_[e]; oo[e] = y_ * cs_.x + (neg ? -p_ : p_) * cs_.y; } \
              A_.x = pk2(oo[0], oo[1]); A_.y = pk2(oo[2], oo[3]); A_.z = pk2(oo[4], oo[5]); A_.w = pk2(oo[6], oo[7]); B_.x = pk2(oo[8], oo[9]); B_.y = pk2(oo[10], oo[11]); B_.z = pk2(oo[12], oo[13]); B_.w = pk2(oo[14], oo[15]); } while (0)
          { int t = gw; u32x4 a = {0u, 0u, 0u, 0u}, c = a; if (t < T) { const u32x4* p = (const u32x4*)(QB + (size_t)t * 1024 + 16 * lane); a = p[0]; c = p[1]; }
            for (; t < T; t += NGW) { const int tn = t + NGW; u32x4 na = a, nc = c; if (tn < T) { const u32x4* p = (const u32x4*)(QB + (size_t)tn * 1024 + 16 * lane); na = p[0]; nc = p[1]; }
                const int sq = t & (SEQ - 1); QK_ROW(a, c, gqv, sq);
                u32x4* q = (u32x4*)(QB + (size_t)t * 1024 + 16 * lane); q[0] = a; q[1] = c; a = na; c = nc; } }
          { const int sub = lane >> 4, l15 = lane & 15; int t4 = gw; u32x4 a = {0u, 0u, 0u, 0u}, c = a;
            if (t4 < T / 4) { const u32x4* p = (const u32x4*)(KVB + (size_t)(t4 * 4 + sub) * 512 + 16 * l15); a = p[0]; c = p[1]; }
            for (; t4 < T / 4; t4 += NGW) { const int tn = t4 + NGW; u32x4 na = a, nc = c; if (tn < T / 4) { const u32x4* p = (const u32x4*)(KVB + (size_t)(tn * 4 + sub) * 512 + 16 * l15); na = p[0]; nc = p[1]; }
                const int sq = (t4 * 4 + sub) & (SEQ - 1); QK_ROW(a, c, gkv, sq);
                u32x4* q = (u32x4*)(KVB + (size_t)(t4 * 4 + sub) * 512 + 16 * l15); q[0] = a; q[1] = c; a = na; c = nc; } }
#undef QK_ROW
        }
        { const float* cw = KARG_PTR(IN_CONVW); const int c8 = (gt & 127) * 8;
          const f32x4 w0a = *(const f32x4*)(cw + c8), w0b = *(const f32x4*)(cw + c8 + 4), w1a = *(const f32x4*)(cw + 1024 + c8), w1b = *(const f32x4*)(cw + 1024 + c8 + 4), w2a = *(const f32x4*)(cw + 2048 + c8), w2b = *(const f32x4*)(cw + 2048 + c8 + 4);
          const int step = ((NGT & 127) == 0) ? NGT : 128 * NGT;
          const u32x4 z = {0u, 0u, 0u, 0u};
#define CV_LOAD(I, PM, PC, PP, CB) do { const int t_ = (I) >> 7, sq_ = t_ & (SEQ - 1); const size_t off_ = (size_t)t_ * 1024 + c8; \
              PM = (sq_ > 0) ? *(const u32x4*)(PROD + off_ - 1024) : z; PC = *(const u32x4*)(PROD + off_); PP = (sq_ < SEQ - 1) ? *(const u32x4*)(PROD + off_ + 1024) : z; CB = *(const u32x4*)(CBB + off_); } while (0)
          u32x4 pm = z, pc = z, pp = z, cb = z; int i = gt;
          if (i < T * 128) CV_LOAD(i, pm, pc, pp, cb);
          for (; i < T * 128; i += step) { const int t = i >> 7;
            u32x4 npm = z, npc = z, npp = z, ncb = z; if (i + step < T * 128) CV_LOAD(i + step, npm, npc, npp, ncb);
            float o[8];
            o[0] = bflo(cb.x) * (w0a[0] * bflo(pm.x) + w1a[0] * bflo(pc.x) + w2a[0] * bflo(pp.x)); o[1] = bfhi(cb.x) * (w0a[1] * bfhi(pm.x) + w1a[1] * bfhi(pc.x) + w2a[1] * bfhi(pp.x));
            o[2] = bflo(cb.y) * (w0a[2] * bflo(pm.y) + w1a[2] * bflo(pc.y) + w2a[2] * bflo(pp.y)); o[3] = bfhi(cb.y) * (w0a[3] * bfhi(pm.y) + w1a[3] * bfhi(pc.y) + w2a[3] * bfhi(pp.y));
            o[4] = bflo(cb.z) * (w0b[0] * bflo(pm.z) + w1b[0] * bflo(pc.z) + w2b[0] * bflo(pp.z)); o[5] = bfhi(cb.z) * (w0b[1] * bfhi(pm.z) + w1b[1] * bfhi(pc.z) + w2b[1] * bfhi(pp.z));
            o[6] = bflo(cb.w) * (w0b[2] * bflo(pm.w) + w1b[2] * bflo(pc.w) + w2b[2] * bflo(pp.w)); o[7] = bfhi(cb.w) * (w0b[3] * bfhi(pm.w) + w1b[3] * bfhi(pc.w) + w2b[3] * bfhi(pp.w));
            u32x4 w; w.x = pk2(o[0], o[1]); w.y = pk2(o[2], o[3]); w.z = pk2(o[4], o[5]); w.w = pk2(o[6], o[7]);
            *(u32x4*)(AC + (size_t)t * DM + 1024 + c8) = w;
            pm = npm; pc = npc; pp = npp; cb = ncb; } }
#undef CV_LOAD
    }
    SEAM(2);

    if (IN(3)) {
        PH_LOCALS
        bf16_t* QB = WSP(bf16_t, WS_Q); bf16_t* KVB = WSP(bf16_t, WS_KV); bf16_t* AC = WSP(bf16_t, WS_XB);
        for (int u = vcu; u < 4 * 8 * 16; u += G) { const int qb = u & 15, bh = u >> 4, h = bh & 7, b = bh >> 3, kvh = h >> 2;
            const size_t r0 = (size_t)b * SEQ;
            attn::attn_dense_body(QB + (r0 + qb * 256) * 1024 + h * 128, KVB + r0 * 512 + kvh * 128, KVB + r0 * 512 + 256 + kvh * 128, AC + (r0 + qb * 256) * DM + h * 128, SEQ, (char*)lds, tid, wave);
            __syncthreads(); }
    }
    SEAM(3);

    if (IN(4)) {
        PH_LOCALS
        bf16_t* AC = WSP(bf16_t, WS_XB); bf16_t* W3AT = WSP(bf16_t, WS_W3AT); unsigned char* SGA = WSP(unsigned char, WS_SGA); unsigned char* SGC = WSP(unsigned char, WS_SGC); bf16_t* MERGED = WSP(bf16_t, WS_MERGED);
        pg8::Gemm g{AC, W3AT, 2 * DM, 2 * DM, 2 * DM, 0}; pg8::StaticOrder S; S.init(T, DM, G, bx);
        pg8::Epi3a E{SGA, SGC, MERGED};
        pg8::gemm_phase<pg8::Epi3a, pg8::StaticOrder>(L, g, S, E, tid, wave);
    }
    SEAM(4);

    if (IN(5)) {
        PH_LOCALS
        const float* x = KARG_PTR(IN_X);
        bf16_t* MERGED = WSP(bf16_t, WS_MERGED); bf16_t* WOUTT = WSP(bf16_t, WS_WOUTT); bf16_t* X1B = WSP(bf16_t, WS_SGA); float* SSQ = WSP(float, WS_SSQ);
        pg8::Gemm g{MERGED, WOUTT, 2 * DM, 2 * DM, 2 * DM, 0}; pg8::StaticOrder S; S.init(T, DM, G, bx);
        pg8::Epi3b E{x, X1B, SSQ};
        pg8::gemm_phase<pg8::Epi3b, pg8::StaticOrder>(L, g, S, E, tid, wave);
    }
    LSEAM(5, 0);

    if (IN(6)) {
        PH_LOCALS
        bf16_t* X1B = WSP(bf16_t, WS_SGA); bf16_t* WQKT = WSP(bf16_t, WS_WQKT); unsigned short* SCORES = WSP(unsigned short, WS_SCORES); bf16_t* PB = WSP(bf16_t, WS_PB); bf16_t* WPLET = WSP(bf16_t, WS_WPLET); bf16_t* PE = WSP(bf16_t, WS_XB);
        { pg8::Gemm g{X1B, WQKT, 2 * DM, 2 * DM, 2 * DM, 0}; pg8::StaticOrder S; S.init(T, DM, G, bx);
          pg8::EpiF16 E{SCORES, DM};
          pg8::gemm_phase<pg8::EpiF16, pg8::StaticOrder>(L, g, S, E, tid, wave); }
    }
    SEAM(6);

    if (IN(7)) {
        PH_LOCALS
        float* SSQ = WSP(float, WS_SSQ); unsigned short* SCORES = WSP(unsigned short, WS_SCORES); bf16_t* X1B = WSP(bf16_t, WS_SGA); bf16_t* UB = WSP(bf16_t, WS_UB); bf16_t* VB = WSP(bf16_t, WS_VB);
        bf16_t* X2B = WSP(bf16_t, WS_X2B); float* XS2 = WSP(float, WS_XS2); unsigned char* X2Q = WSP(unsigned char, WS_X2Q); const float* SV = WSP(float, WS_SV); const float* SU = WSP(float, WS_SU); unsigned char* XD = WSP(unsigned char, WS_XD);
        LAS unsigned char* Lw = L + wave * 20096;
        LAS unsigned* LK = (LAS unsigned*)(Lw);
        LAS float* SELV = (LAS float*)(Lw + 1024);
        LAS unsigned* SELI = (LAS unsigned*)(Lw + 1536);
        LAS unsigned* EIT = (LAS unsigned*)(Lw + 2048);
        LAS float* HIT = (LAS float*)(Lw + 6144);
        LAS float* RST = (LAS float*)(Lw + 19456);
        LAS float* HSQ = (LAS float*)(Lw + 19488);
        LAS float* AM1 = (LAS float*)(Lw + 19520);
        LAS float* STG = (LAS float*)(Lw + 10240);
        LAS float* ACT = (LAS float*)(Lw + 10240);
        constexpr int TPW = 8;
        for (int tb = gw * TPW; tb < T; tb += NGW * TPW) {
#pragma unroll 1
            for (int ti = 0; ti < TPW; ++ti) {
                const int t = tb + ti;
                int ln_ = lane; asm volatile("" : "+v"(ln_));
                float rstd1;
                unsigned ka[16], kb[16];
                {
                  const u32x4* sp = (const u32x4*)((const char*)SCORES + (unsigned)t * (DM * 2u) + 64u * ln_); u32x4 fr[4];
#pragma unroll
                  for (int j = 0; j < 4; ++j) fr[j] = sp[j];
                  {
                    const u32x4* xp = (const u32x4*)((const char*)X1B + ((unsigned)t * DM + 32u * ln_) * 2u); u32x4 xr[4];
#pragma unroll
                    for (int q = 0; q < 4; ++q) xr[q] = xp[q];
                    float am = 0.f, ssl = 0.f;
#pragma unroll
                    for (int q = 0; q < 4; ++q)
#pragma unroll
                        for (int c = 0; c < 4; ++c) { const float e0 = bflo(xr[q][c]), e1 = bfhi(xr[q][c]); am = fmaxf(am, fmaxf(fabsf(e0), fabsf(e1))); ssl = fmaf(e0, e0, fmaf(e1, e1, ssl)); }
                    rstd1 = 1.0f / sqrtf(wave_sum(ssl) * (1.0f / DM) + EPS);
                    am = fmaxf(am, dppf<DPP_X1>(am)); am = fmaxf(am, dppf<DPP_X2>(am)); am = fmaxf(am, dppf<DPP_HMIR>(am)); am = fmaxf(am, dppf<DPP_MIR>(am));
                    am = fmaxf(am, __shfl_xor(am, 16)); am = fmaxf(am, __shfl_xor(am, 32));
                    const float qs = am > 0.f ? 119.0f / am : 0.f; u32x4 dh, dl; unsigned sqb = 0u;
#pragma unroll
                    for (int q = 0; q < 4; ++q) { unsigned ya = 0u, yb = 0u;
#pragma unroll
                        for (int i = 0; i < 8; ++i) { const unsigned wv = xr[q][i >> 1]; const int y = (int)fmaf((i & 1) ? bfhi(wv) : bflo(wv), qs, 136.5f);
                            if (i < 4) ya = __builtin_amdgcn_alignbit((unsigned)y, ya, 8); else yb = __builtin_amdgcn_alignbit((unsigned)y, yb, 8); }
                        sqb = __builtin_amdgcn_sad_u8(ya, 0u, sqb); sqb = __builtin_amdgcn_sad_u8(yb, 0u, sqb);
                        dl[q] = ((ya & 0x0F0F0F0Fu) | ((yb & 0x0F0F0F0Fu) << 4)) ^ 0x88888888u;
                        dh[q] = (((ya >> 4) & 0x0F0F0F0Fu) | (yb & 0xF0F0F0F0u)) ^ 0x88888888u; }
                    const int sq = (int)sqb - 136 * 32;
                    *(u32x4*)(XD + ((unsigned)t * 2048u + 32u * ln_)) = dh; *(u32x4*)(XD + ((unsigned)t * 2048u + 32u * ln_ + 16u)) = dl;
                    float sqf = (float)sq; sqf = wave_sum(sqf);
                    if (ln_ == 0) { RST[ti] = rstd1 * (am * (1.0f / 119.0f)); HSQ[ti] = 0.5f * sqf; AM1[ti] = am; } }
                  const u32x4* lp = fr; const unsigned nb = (unsigned)(lane & 3) * 32u;
#pragma unroll
                  for (int j = 0; j < 2; ++j) { const u32x4 v = lp[j];
#pragma unroll
                      for (int c = 0; c < 4; ++c) { const unsigned w_ = v[c], o_ = h2ord2(w_);
                          ka[8 * j + 2 * c] = (o_ << 16) | (nb + 8 * j + 2 * c); ka[8 * j + 2 * c + 1] = (o_ & 0xFFFF0000u) | (nb + 8 * j + 2 * c + 1); } }
#pragma unroll
                  for (int j = 0; j < 2; ++j) { const u32x4 v = lp[2 + j];
#pragma unroll
                      for (int c = 0; c < 4; ++c) { const unsigned w_ = v[c], o_ = h2ord2(w_);
                          kb[8 * j + 2 * c] = (o_ << 16) | (nb + 16 + 8 * j + 2 * c); kb[8 * j + 2 * c + 1] = (o_ & 0xFFFF0000u) | (nb + 16 + 8 * j + 2 * c + 1); } }
                  LDS_WAIT(); }
                sort16_desc(ka); sort16_desc(kb);
                unsigned kc[16];
#pragma unroll
                for (int i = 0; i < 16; ++i) kc[i] = umax_(ka[i], kb[15 - i]);
                bitonic_merge_desc<16>(kc);
#pragma unroll
                for (int i = 0; i < 16; ++i) ka[i] = umax_(kc[i], dppu<DPP_X1>(kc[15 - i]));
                bitonic_merge_desc<16>(ka);
#pragma unroll
                for (int i = 0; i < 16; ++i) kc[i] = umax_(ka[i], dppu<DPP_X2>(ka[15 - i]));
                bitonic_merge_desc<16>(kc);
                if ((lane & 3) == 0) {
#pragma unroll
                    for (int i = 0; i < 4; ++i) { u32x4 w = {kc[4 * i], kc[4 * i + 1], kc[4 * i + 2], kc[4 * i + 3]}; *(LAS u32x4*)(LK + (lane >> 2) * 16 + 4 * i) = w; } }
                LDS_WAIT();
                { const int h = lane >> 3, j = lane & 7;
                  const LAS unsigned* L0 = LK + (2 * h) * 16; const LAS unsigned* L1 = LK + (2 * h + 1) * 16;
                  const unsigned k0a = L0[j], k0e = L0[j + 8], k10 = L1[0];
                  const float v0a = okey2f(k0a), v0e = okey2f(k0e), v10 = okey2f(k10);
                  const unsigned i0a = k0a & 0x7Fu, i0e = k0e & 0x7Fu, i10 = k10 & 0x7Fu;
                  float fv = v0a + v10; unsigned fi1 = i10; int ptr = 0; bool fvalid = true;
                  const float ev = v0e + v10; bool evalid = true;
                  for (int r = 0; r < 16; ++r) {
                      const unsigned kf = fvalid ? ((f2ord(fv) & ~0xFu) | (unsigned)(j << 1)) : 0u;
                      const unsigned ke = evalid ? ((f2ord(ev) & ~0xFu) | (unsigned)(j << 1) | 1u) : 0u;
                      unsigned gm = umax_(kf, ke);
                      gm = umax_(gm, dppu<DPP_X1>(gm)); gm = umax_(gm, dppu<DPP_X2>(gm)); gm = umax_(gm, dppu<DPP_HMIR>(gm));
                      if (fvalid && gm == kf) {
                          SELV[h * 16 + r] = fv; SELI[h * 16 + r] = i0a * 128u + fi1;
                          ++ptr;
                          if (ptr < 16) { const unsigned kk = L1[ptr]; fv = v0a + okey2f(kk); fi1 = kk & 0x7Fu; } else fvalid = false;
                      } else if (evalid && gm == ke) {
                          SELV[h * 16 + r] = ev; SELI[h * 16 + r] = i0e * 128u + i10; evalid = false;
                      }
                  } }
                LDS_WAIT();
                { const float m0 = rstd1 * SELV[lane & ~15], m1 = rstd1 * SELV[64 + (lane & ~15)];
                  const float p0 = __expf(rstd1 * SELV[lane] - m0), p1 = __expf(rstd1 * SELV[64 + lane] - m1);
                  float s0 = p0, s1 = p1;
                  s0 += dppf<DPP_X1>(s0); s0 += dppf<DPP_X2>(s0); s0 += dppf<DPP_HMIR>(s0); s0 += dppf<DPP_MIR>(s0);
                  s1 += dppf<DPP_X1>(s1); s1 += dppf<DPP_X2>(s1); s1 += dppf<DPP_HMIR>(s1); s1 += dppf<DPP_MIR>(s1);
                  EIT[ti * 128 + lane] = SELI[lane] * 128u; EIT[ti * 128 + 64 + lane] = SELI[64 + lane] * 128u;
                  HIT[ti * 128 + lane] = p0 / s0; HIT[ti * 128 + 64 + lane] = p1 / s1;
                  }
                LDS_WAIT();
            }
            const int lg = lane >> 3, l16 = (lane & 7) * 16;
            asm volatile("s_waitcnt vmcnt(0)" ::: "memory");
            static_assert(TPW == 8, "u sweep and v sweep: 8 tokens per wave");
            { int acc[8][16];
#pragma unroll
              for (int i = 0; i < 8; ++i)
#pragma unroll
                  for (int k = 0; k < 16; ++k) acc[i][k] = 0;
              LAS unsigned char* XL = Lw + 14336;
              const unsigned xsrc_ = (unsigned)(tb + (lane >> 3)) * 2048u + (unsigned)(lane & 7) * 32u;
#define U_ISSUE(W, X, xbuf, cc, tok, hf) do { \
                _Pragma("unroll") for (int g = 0; g < 2; ++g) { unsigned e_[4]; \
                    _Pragma("unroll") for (int k = 0; k < 4; ++k) e_[k] = eit[(tok) * 128 + 8 * (8 * (hf) + 4 * g + k)]; \
                    _Pragma("unroll") for (int k = 0; k < 4; ++k) W[4 * g + k] = *(const u32x4*)((const unsigned char*)UB + (e_[k] + (unsigned)(cc) * (16384u * 128u) + (unsigned)l16)); \
                    __builtin_amdgcn_sched_barrier(0); } } while (0)
#define U_COMPUTE(W, X, xbuf, tok, hf) do {     \
                { const LAS unsigned char* xp_ = XL + (xbuf) * 2048 + (tok) * 256 + 2 * l16; X[0] = *(const LAS u32x4*)(xp_); X[1] = *(const LAS u32x4*)(xp_ + 16); } \
                _Pragma("unroll") for (int k = 0; k < 8; ++k) { int th = 0, d = acc[tok][8 * (hf) + k]; \
                    _Pragma("unroll") for (int q = 0; q < 4; ++q) { th = __builtin_amdgcn_sdot8((int)W[k][q], (int)X[0][q], th, false); d = __builtin_amdgcn_sdot8((int)W[k][q], (int)X[1][q], d, false); } \
                    acc[tok][8 * (hf) + k] = d + (th << 4); } \
                __builtin_amdgcn_sched_barrier(0); } while (0)
              u32x4 wA[8], wB[8], xA[2];
              { const u32x4 x0_ = *(const u32x4*)(XD + xsrc_), x1_ = *(const u32x4*)(XD + xsrc_ + 16u); *(LAS u32x4*)(XL + 32 * lane) = x0_; *(LAS u32x4*)(XL + 32 * lane + 16) = x1_; LDS_WAIT(); }
              { const LAS unsigned* eit = EIT + lg; U_ISSUE(wA, xA, 0, 0, 0, 0); }
#pragma unroll 1
              for (int c = 0; c < 8; ++c) {
                  int zo = 0; asm volatile("" : "+v"(zo));
                  const LAS unsigned* eit = EIT + lg + zo; const int cn = (c < 7) ? c + 1 : 7; const int xb_ = c & 1;
                  U_ISSUE(wB, xA, xb_, c, 0, 1); U_COMPUTE(wA, xA, xb_, 0, 0);
                  U_ISSUE(wA, xA, xb_, c, 1, 0); U_COMPUTE(wB, xA, xb_, 0, 1);
                  U_ISSUE(wB, xA, xb_, c, 1, 1); U_COMPUTE(wA, xA, xb_, 1, 0);
                  U_ISSUE(wA, xA, xb_, c, 2, 0); U_COMPUTE(wB, xA, xb_, 1, 1);
                  U_ISSUE(wB, xA, xb_, c, 2, 1); U_COMPUTE(wA, xA, xb_, 2, 0);
                  U_ISSUE(wA, xA, xb_, c, 3, 0); U_COMPUTE(wB, xA, xb_, 2, 1);
                  U_ISSUE(wB, xA, xb_, c, 3, 1); U_COMPUTE(wA, xA, xb_, 3, 0);
                  U_ISSUE(wA, xA, xb_, c, 4, 0); U_COMPUTE(wB, xA, xb_, 3, 1);
                  U_ISSUE(wB, xA, xb_, c, 4, 1); U_COMPUTE(wA, xA, xb_, 4, 0);
                  U_ISSUE(wA, xA, xb_, c, 5, 0); U_COMPUTE(wB, xA, xb_, 4, 1);
                  U_ISSUE(wB, xA, xb_, c, 5, 1); U_COMPUTE(wA, xA, xb_, 5, 0);
                  U_ISSUE(wA, xA, xb_, c, 6, 0); U_COMPUTE(wB, xA, xb_, 5, 1);
                  { const u32x4 xn_ = *(const u32x4*)(XD + (xsrc_ + 256u * (unsigned)cn));
                    U_ISSUE(wB, xA, xb_, c, 6, 1); U_COMPUTE(wA, xA, xb_, 6, 0);
                    *(LAS u32x4*)(XL + (xb_ ^ 1) * 2048 + 32 * lane) = xn_; }
                  { const u32x4 xn_ = *(const u32x4*)(XD + (xsrc_ + 256u * (unsigned)cn + 16u));
                    U_ISSUE(wA, xA, xb_, c, 7, 0); U_COMPUTE(wB, xA, xb_, 6, 1);
                    *(LAS u32x4*)(XL + (xb_ ^ 1) * 2048 + 32 * lane + 16) = xn_; }
                  U_ISSUE(wB, xA, xb_, c, 7, 1); U_COMPUTE(wA, xA, xb_, 7, 0);
                  LDS_WAIT();
                  U_ISSUE(wA, xA, xb_ ^ 1, cn, 0, 0); U_COMPUTE(wB, xA, xb_, 7, 1);
              }
#undef U_ISSUE
#undef U_COMPUTE
              { int lane3h_ = lane; asm volatile("" : "+v"(lane3h_)); const int lg3 = lane3h_ >> 3;
#pragma unroll
                for (int i = 0; i < 8; ++i)
#pragma unroll
                    for (int k = 0; k < 16; ++k) { unsigned d = (unsigned)acc[i][k]; d += dppu<DPP_X1>(d); d += dppu<DPP_X2>(d); d += dppu<DPP_HMIR>(d); if ((lane3h_ & 7) == 0) ACT[i * 128 + 8 * k + lg3] = (float)(int)d; } }
            }
            int lane3_ = lane; asm volatile("" : "+v"(lane3_));
            LDS_WAIT();
#pragma unroll 1
            for (int i = 0; i < TPW; ++i) { const float r1 = RST[i], hq = HSQ[i];
#pragma unroll
                for (int hh = 0; hh < 2; ++hh) { const int j = i * 128 + 64 * hh + lane3_; const unsigned ej = EIT[j] >> 7; const float a = r1 * SU[ej] * (ACT[j] + hq); const float svj = SV[ej];
                    HIT[j] = 0.5f * a * (1.0f + erff(a * 0.70710678118654752f)) * HIT[j] * svj; } }
            LDS_WAIT();
            { LAS unsigned short* E16 = (LAS unsigned short*)Lw; LAS unsigned* HDW = (LAS unsigned*)(Lw + 2048); LAS float* SH = (LAS float*)(Lw + 3072); LAS float* SQH = SH + 8;
              LAS unsigned char* YB = Lw + 10240; LAS unsigned char* RING = Lw + 3584;
              { unsigned ev[16];
#pragma unroll
                for (int k = 0; k < 16; ++k) ev[k] = EIT[64 * k + lane3_] >> 7;
                LDS_WAIT();
#pragma unroll
                for (int k = 0; k < 16; ++k) E16[64 * k + lane3_] = (unsigned short)ev[k];
                LDS_WAIT(); }
#pragma unroll 1
              for (int i = 0; i < TPW; ++i) {
                  const float h0 = HIT[i * 128 + lane3_], h1 = HIT[i * 128 + 64 + lane3_];
                  float hm = fmaxf(fabsf(h0), fabsf(h1));
                  hm = fmaxf(hm, dppf<DPP_X1>(hm)); hm = fmaxf(hm, dppf<DPP_X2>(hm)); hm = fmaxf(hm, dppf<DPP_HMIR>(hm)); hm = fmaxf(hm, dppf<DPP_MIR>(hm));
                  hm = fmaxf(hm, __shfl_xor(hm, 16)); hm = fmaxf(hm, __shfl_xor(hm, 32));
                  const float qs = hm > 0.f ? 119.0f / hm : 0.f;
                  const int y0 = (int)floorf(fmaf(h0, qs, 8.5f)), y1 = (int)floorf(fmaf(h1, qs, 8.5f));
                  float sqf = (float)(y0 + y1 - 16); sqf = wave_sum(sqf);
                  YB[i * 128 + lane3_] = (unsigned char)y0; YB[i * 128 + 64 + lane3_] = (unsigned char)y1;
                  if (lane3_ == 0) { SH[i] = hm * (1.0f / 119.0f); SQH[i] = 0.5f * sqf; } }
              LDS_WAIT();
#pragma unroll
              for (int r = 0; r < 2; ++r) {
                  const int pi = lane3_ + 64 * r; const u32x2 yy = *(const LAS u32x2*)(YB + 8 * pi);
                  unsigned la = yy.x & 0x0F0F0F0Fu, lb = yy.y & 0x0F0F0F0Fu, ha = (yy.x >> 4) & 0x0F0F0F0Fu, hb = (yy.y >> 4) & 0x0F0F0F0Fu;
                  la = (la | (la >> 4)) & 0x00FF00FFu; la = (la | (la >> 8)) & 0xFFFFu; lb = (lb | (lb >> 4)) & 0x00FF00FFu; lb = (lb | (lb >> 8)) & 0xFFFFu;
                  ha = (ha | (ha >> 4)) & 0x00FF00FFu; ha = (ha | (ha >> 8)) & 0xFFFFu; hb = (hb | (hb >> 4)) & 0x00FF00FFu; hb = (hb | (hb >> 8)) & 0xFFFFu;
                  u32x2 hw; hw.x = ha | (hb << 16); hw.y = (la | (lb << 16)) ^ 0x88888888u;
                  *(LAS u32x2*)(HDW + 2 * pi) = hw; }
              LDS_WAIT();
              const int dr = lane3_ >> 3, dP = lane3_ & 7;
              const unsigned goff0 = 16u * (unsigned)(dP ^ (dr >> 1)), goff1 = 16u * (unsigned)(dP ^ (4 + (dr >> 1)));
              const int g4 = lane3_ >> 4, q16 = lane3_ & 15;
              const unsigned trb = (unsigned)((q16 >> 3) * 1024 + (q16 & 7) * 128 + 8 * (g4 & 1));
              unsigned tra[4];
#pragma unroll
              for (int sl = 0; sl < 4; ++sl) tra[sl] = (unsigned)(__SIZE_TYPE__)RING + trb + 16u * (unsigned)((2 * sl + (g4 >> 1)) ^ (q16 >> 1));
#define VS_ISSUE(cc, ii, rb) do { const unsigned e0_ = E16[(ii) * 128 + 16 * (rb) + dr], e1_ = E16[(ii) * 128 + 16 * (rb) + 8 + dr]; \
                  const unsigned char* gb_ = (const unsigned char*)VB + (unsigned)(cc) * (16384u * 128u); \
                  __builtin_amdgcn_global_load_lds((const unsigned*)(gb_ + (e0_ * 128u + goff0)), (LAS unsigned*)(RING + (rb) * 2048), 16, 0, 16); \
                  __builtin_amdgcn_global_load_lds((const unsigned*)(gb_ + (e1_ * 128u + goff1)), (LAS unsigned*)(RING + (rb) * 2048 + 1024), 16, 0, 16); } while (0)
              float am2[TPW], ss2[TPW];
#pragma unroll
              for (int i = 0; i < TPW; ++i) { am2[i] = 0.f; ss2[i] = 0.f; }
              float bnd[TPW], scp[TPW];
#pragma unroll
              for (int i = 0; i < TPW; ++i) { bnd[i] = 1.25f * AM1[i]; scp[i] = bnd[i] > 0.f ? 127.0f / bnd[i] : 0.f; }
              LDS_WAIT();
#pragma unroll
              for (int rb = 0; rb < 7; ++rb) VS_ISSUE(0, 0, rb);
#pragma unroll 1
              for (int c = 0; c < 8; ++c) {
#pragma unroll
                  for (int i = 0; i < TPW; ++i) {
                      const unsigned xo_ = ((unsigned)(tb + i) * DM + 256u * (unsigned)c + 4u * (unsigned)lane3_) * 2u;
                      const u32x2 x1v = *(const u32x2*)((const char*)X1B + xo_);
                      int aH[4] = {0, 0, 0, 0}, aL[4] = {0, 0, 0, 0};
#pragma unroll
                      for (int rb = 0; rb < 8; ++rb) {
                          const int nrb = (rb + 7) & 7, ni = i + ((rb + 7) >> 3);
                          if (ni < TPW) { VS_ISSUE(c, ni, nrb); } else { const int cn = (c < 7) ? c + 1 : 7, in_ = (c < 7) ? 0 : 7; VS_ISSUE(cn, in_, nrb); }
                          asm volatile("s_waitcnt vmcnt(14)" ::: "memory");
                          const u32x4 hd = *(const LAS u32x4*)(HDW + (i * 8 + rb) * 4);
                          i32x2 w[4];
#pragma unroll
                          for (int sl = 0; sl < 4; ++sl) asm volatile("ds_read_b64_tr_b4 %0, %1 offset:%2" : "=v"(w[sl]) : "v"(tra[sl]), "i"(rb * 2048) : "memory");
                          asm volatile("s_waitcnt lgkmcnt(0)" : "+v"(w[0]), "+v"(w[1]), "+v"(w[2]), "+v"(w[3]) :: "memory");
#pragma unroll
                          for (int sl = 0; sl < 4; ++sl) { aH[sl] = __builtin_amdgcn_sdot8(w[sl].x, (int)hd.x, aH[sl], false); aH[sl] = __builtin_amdgcn_sdot8(w[sl].y, (int)hd.z, aH[sl], false);
                              aL[sl] = __builtin_amdgcn_sdot8(w[sl].x, (int)hd.y, aL[sl], false); aL[sl] = __builtin_amdgcn_sdot8(w[sl].y, (int)hd.w, aL[sl], false); }
                      }
                      const float sh = SH[i], sq = SQH[i];
                      float fo[4];
#pragma unroll
                      for (int sl = 0; sl < 4; ++sl) { const unsigned xw_ = (sl < 2) ? x1v.x : x1v.y; const float f = ((sl & 1) ? bfhi(xw_) : bflo(xw_)) + sh * ((float)((aH[sl] << 4) + aL[sl]) + sq);
                          am2[i] = fmaxf(am2[i], fabsf(f)); ss2[i] += f * f; fo[sl] = f; }
                      { u32x2 xw2; xw2.x = pk2(fo[0], fo[1]); xw2.y = pk2(fo[2], fo[3]); *(u32x2*)((char*)X2B + xo_) = xw2;
                        *(unsigned*)(X2Q + (xo_ >> 1)) = q8x4(fo[0] * scp[i], fo[1] * scp[i], fo[2] * scp[i], fo[3] * scp[i]); }
                  }
              }
#undef VS_ISSUE
              unsigned viol = 0u; float amx[TPW];
#pragma unroll
              for (int i = 0; i < TPW; ++i) { float am = am2[i];
                  am = fmaxf(am, dppf<DPP_X1>(am)); am = fmaxf(am, dppf<DPP_X2>(am)); am = fmaxf(am, dppf<DPP_HMIR>(am)); am = fmaxf(am, dppf<DPP_MIR>(am));
                  am = fmaxf(am, __shfl_xor(am, 16)); am = fmaxf(am, __shfl_xor(am, 32));
                  const float ssum = wave_sum(ss2[i]); const bool v_ = am > bnd[i]; const float rng = v_ ? am : bnd[i];
                  if (lane3_ == 0) XS2[tb + i] = (1.0f / sqrtf(ssum * (1.0f / DM) + EPS)) * rng * (1.0f / 127.0f);
                  amx[i] = am; viol |= v_ ? (1u << i) : 0u; }
              if (viol) { asm volatile("s_waitcnt vmcnt(0)" ::: "memory");
#pragma unroll
                  for (int i = 0; i < TPW; ++i) if (viol & (1u << i)) { const float s_ = amx[i] > 0.f ? 127.0f / amx[i] : 0.f; u32x4 p[4], o8[2];
#pragma unroll
                      for (int q = 0; q < 4; ++q) p[q] = *(const u32x4*)((const char*)X2B + ((unsigned)(tb + i) * DM + 32u * (unsigned)lane3_) * 2u + 16 * q);
#pragma unroll
                      for (int h = 0; h < 2; ++h) { const u32x4 p0 = p[2 * h], p1 = p[2 * h + 1];
                          o8[h][0] = q8x4(bflo(p0.x) * s_, bfhi(p0.x) * s_, bflo(p0.y) * s_, bfhi(p0.y) * s_); o8[h][1] = q8x4(bflo(p0.z) * s_, bfhi(p0.z) * s_, bflo(p0.w) * s_, bfhi(p0.w) * s_);
                          o8[h][2] = q8x4(bflo(p1.x) * s_, bfhi(p1.x) * s_, bflo(p1.y) * s_, bfhi(p1.y) * s_); o8[h][3] = q8x4(bflo(p1.z) * s_, bfhi(p1.z) * s_, bflo(p1.w) * s_, bfhi(p1.w) * s_); }
                      u32x4* dst = (u32x4*)(X2Q + ((unsigned)(tb + i) * DM + 32u * (unsigned)lane3_)); dst[0] = o8[0]; dst[1] = o8[1]; } }
            }
        }
    }
    LSEAM(7, 2);

    if (IN(8)) {
        PH_LOCALS
        bf16_t* X2B = WSP(bf16_t, WS_X2B); unsigned char* X2Q = WSP(unsigned char, WS_X2Q); unsigned char* WGQ = WSP(unsigned char, WS_WGQ); bf16_t* PE = WSP(bf16_t, WS_XB); float* XS2 = WSP(float, WS_XS2);
        const float* CMAXF = WSP(float, WS_CMAX);
        bf16_t* PB = WSP(bf16_t, WS_PB); bf16_t* WPLET = WSP(bf16_t, WS_WPLET); unsigned char* G8 = WSP(unsigned char, WS_G8);
        { pg8::Gemm g{X2Q, WGQ, DM, DM, DM, 0}; pg8::StaticOrder S; S.init(T, DM, G, bx);
          pg8::Epi8a E{G8, XS2, CMAXF + W_IN};
          pg8::gemm_phase<pg8::Epi8a, pg8::StaticOrder, true>(L, g, S, E, tid, wave); }
        { pg8::Gemm g{PB, WPLET, 512, 512, 512, 0}; pg8::StaticOrder S; S.init(T, DM, G, bx);
          pg8::Epi8b E{out, X2B, G8};
          pg8::gemm_phase<pg8::Epi8b, pg8::StaticOrder>(L, g, S, E, tid, wave); }
    }
#undef IN
#undef SEAM
}

extern "C" void kernel_launch(void* const* d_in, const int* in_sizes, int n_in, void* d_out, int out_size, void* d_ws, size_t ws_size, hipStream_t stream) {
    static int grid = 0;
    if (grid == 0) {
        if (n_in != 18 || in_sizes[0] != T * DM || out_size != T * DM || ws_size < WS_END) {
            fprintf(stderr, "kernel_launch: unexpected shapes: n_in %d in0 %d out %d ws %zu (need %zu); nothing launched\n", n_in, n_in > 0 ? in_sizes[0] : -1, out_size, ws_size, (size_t)WS_END); grid = -1; return; }
        int dev = 0, cus = 0, per_cu = 0;
        if (hipGetDevice(&dev) != hipSuccess || hipDeviceGetAttribute(&cus, hipDeviceAttributeMultiprocessorCount, dev) != hipSuccess) { fprintf(stderr, "kernel_launch: device query failed\n"); grid = -1; return; }
        if (hipFuncSetAttribute((const void*)mega_fwd, hipFuncAttributeMaxDynamicSharedMemorySize, LDS_BYTES) != hipSuccess) { fprintf(stderr, "kernel_launch: hipFuncSetAttribute failed\n"); grid = -1; return; }
        if (hipOccupancyMaxActiveBlocksPerMultiprocessor(&per_cu, (const void*)mega_fwd, NW * 64, LDS_BYTES) != hipSuccess || per_cu < 1) { fprintf(stderr, "kernel_launch: occupancy query says %d blocks/CU\n", per_cu); (void)hipGetLastError(); grid = -1; return; }
        grid = cus;
    }
    if (grid < 0) return;
    if (hipMemsetAsync((char*)d_ws + WS_CTL, 0, CTL_BYTES, stream) != hipSuccess) { fprintf(stderr, "kernel_launch: hipMemsetAsync failed\n"); return; }
    Args a{};
    for (int i = 0; i < 18; ++i) a.in[i] = (const float*)d_in[i];
    a.out = (float*)d_out; a.ws = (unsigned char*)d_ws;
    constexpr int NPH = 9;
    a.ph_lo = 0; a.ph_hi = NPH;
    { void* kargs[] = {&a}; hipError_t e = hipLaunchCooperativeKernel((void*)mega_fwd, dim3(grid), dim3(NW * 64), kargs, LDS_BYTES, stream);
      if (e != hipSuccess) fprintf(stderr, "kernel_launch: cooperative launch failed: %s (grid %d)\n", hipGetErrorString(e), grid); }
}
```
